# Optimizing an MI355X kernel written in HIP

```python
import jax
import jax.numpy as jnp
from jax import lax
import numpy as np


D_MODEL = 1024
BATCH = 8
SEQ = 4096
DEPTH = 2

NSA_HEADS = 8
NSA_GROUPS = 2
NSA_HEADS_PER_GROUP = NSA_HEADS // NSA_GROUPS
HEAD_DIM = 64
NSA_WIDTH = NSA_HEADS * HEAD_DIM
NSA_KV = NSA_GROUPS * HEAD_DIM
CMP_BLOCK = 32
CMP_STRIDE = 16
CMP_HIDDEN = 128
SLC_BLOCK = 64
SLC_TOPK = 16
WINDOW = 512
NSA_QBLOCK = 64
GLA_HEADS = 4
GLA_KEY_HEAD = 64
GLA_VALUE_HEAD = 128
GLA_KEY_DIM = GLA_HEADS * GLA_KEY_HEAD
GLA_VALUE_DIM = GLA_HEADS * GLA_VALUE_HEAD
GLA_GATE_RANK = 16
GLA_TAU = 16.0
GLA_CHUNK = 64
ROPE_THETA = 10000.0
NORM_EPS = 1e-6
N_BRANCHES = 2
IN_SPLITS = (NSA_WIDTH, NSA_KV, NSA_KV, NSA_KV, NSA_KV, NSA_KV, NSA_KV, 3 * NSA_HEADS, NSA_WIDTH,
             GLA_KEY_DIM, GLA_KEY_DIM, GLA_VALUE_DIM, GLA_GATE_RANK, GLA_VALUE_DIM, N_BRANCHES * D_MODEL)
D_IN = (2 * NSA_WIDTH + 6 * NSA_KV + 3 * NSA_HEADS + 2 * GLA_KEY_DIM + 2 * GLA_VALUE_DIM
        + GLA_GATE_RANK + N_BRANCHES * D_MODEL)

kernel_name = 'nsa_gla_gated_hybrid_trunk'


def _rms(x, g):
    xf = x.astype(jnp.float32)
    y = xf * lax.rsqrt(jnp.mean(xf * xf, axis=-1, keepdims=True) + NORM_EPS)
    return (y * g.astype(jnp.float32)).astype(x.dtype)


def _rope(x, cos, sin):
    x1, x2 = jnp.split(x.astype(jnp.float32), 2, axis=-1)
    c = cos[None, :, None, :]
    s = sin[None, :, None, :]
    return jnp.concatenate([x1 * c - x2 * s, x2 * c + x1 * s], axis=-1).astype(x.dtype)


def _masked_softmax(s, mask):
    s = jnp.where(mask, s.astype(jnp.float32), -jnp.inf)
    m = jnp.max(s, axis=-1, keepdims=True)
    m = jnp.where(jnp.isfinite(m), m, 0.0)
    e = jnp.where(mask, jnp.exp(s - m), 0.0)
    return e / jnp.maximum(jnp.sum(e, axis=-1, keepdims=True), 1e-30)


def _compress(kraw, pos_emb, w1, w2):
    S = kraw.shape[1]
    ncmp = (S - CMP_BLOCK) // CMP_STRIDE + 1
    idx = CMP_STRIDE * jnp.arange(ncmp)[:, None] + jnp.arange(CMP_BLOCK)[None, :]
    blocks = kraw[:, idx] + pos_emb[None, None, :, None, :]
    hid = jax.nn.silu(jnp.einsum('bjlgd,ldh->bjgh', blocks, w1))
    return jnp.einsum('bjgh,hd->bgjd', hid, w2)


def _nsa_attention(q_rope, q_nope, k_cmp, v_cmp, k_slc, v_slc, k_win, v_win, gate):
    B, S, G, HG, d = q_rope.shape
    scale = d ** -0.5
    ncmp = k_cmp.shape[2]
    nblk = S // SLC_BLOCK
    topk = min(SLC_TOPK, nblk)
    nq = S // NSA_QBLOCK
    cs = CMP_STRIDE * jnp.arange(ncmp)
    cmp_end = cs + CMP_BLOCK - 1
    bs = SLC_BLOCK * jnp.arange(nblk)
    overlap = ((cs[:, None] < bs[None, :] + SLC_BLOCK) & (cs[:, None] + CMP_BLOCK > bs[None, :])).astype(jnp.float32)
    ks_blk = k_slc.reshape(B, nblk, SLC_BLOCK, G, d).transpose(0, 3, 1, 2, 4)
    vs_blk = v_slc.reshape(B, nblk, SLC_BLOCK, G, d).transpose(0, 3, 1, 2, 4)
    kw_pad = jnp.pad(k_win, ((0, 0), (WINDOW, 0), (0, 0), (0, 0)))
    vw_pad = jnp.pad(v_win, ((0, 0), (WINDOW, 0), (0, 0), (0, 0)))
    b_ix = jnp.arange(B)[:, None, None, None]
    g_ix = jnp.arange(G)[None, :, None, None]
    blk_ids = jnp.arange(nblk)

    def query_block(i):
        start = i * NSA_QBLOCK
        t = start + jnp.arange(NSA_QBLOCK)
        qr = lax.dynamic_slice_in_dim(q_rope, start, NSA_QBLOCK, axis=1)
        qn = lax.dynamic_slice_in_dim(q_nope, start, NSA_QBLOCK, axis=1)
        gt = lax.dynamic_slice_in_dim(gate, start, NSA_QBLOCK, axis=1)
        s_c = jnp.einsum('bqghd,bgjd->bghqj', qn, k_cmp) * scale
        p_c = _masked_softmax(s_c, cmp_end[None, :] <= t[:, None])
        o_c = jnp.einsum('bghqj,bgjd->bqghd', p_c.astype(v_cmp.dtype), v_cmp)
        imp = jnp.einsum('bghqj,jn->bgqn', p_c, overlap)
        cur = t // SLC_BLOCK
        forced = ((blk_ids[None, :] == 0) | (blk_ids[None, :] == cur[:, None])
                  | (blk_ids[None, :] == cur[:, None] - 1))
        valid = bs[None, :] <= t[:, None]
        imp = jnp.where(forced, jnp.inf, jnp.where(valid, imp, -jnp.inf))
        _, sel = lax.top_k(imp, topk)
        k_sel = ks_blk[b_ix, g_ix, sel]
        v_sel = vs_blk[b_ix, g_ix, sel]
        kpos = sel[..., None] * SLC_BLOCK + jnp.arange(SLC_BLOCK)
        m_s = (kpos <= t[None, None, :, None, None]).reshape(B, G, 1, NSA_QBLOCK, topk * SLC_BLOCK)
        s_s = jnp.einsum('bqghd,bgqkld->bghqkl', qr, k_sel).reshape(B, G, HG, NSA_QBLOCK, topk * SLC_BLOCK) * scale
        p_s = _masked_softmax(s_s, m_s).reshape(B, G, HG, NSA_QBLOCK, topk, SLC_BLOCK)
        o_s = jnp.einsum('bghqkl,bgqkld->bqghd', p_s.astype(v_sel.dtype), v_sel)
        kwin = lax.dynamic_slice_in_dim(kw_pad, start, WINDOW + NSA_QBLOCK, axis=1)
        vwin = lax.dynamic_slice_in_dim(vw_pad, start, WINDOW + NSA_QBLOCK, axis=1)
        kp = start - WINDOW + jnp.arange(WINDOW + NSA_QBLOCK)
        m_w = (kp[None, :] >= 0) & (kp[None, :] <= t[:, None]) & (kp[None, :] > t[:, None] - WINDOW)
        s_w = jnp.einsum('bqghd,bkgd->bghqk', qr, kwin) * scale
        p_w = _masked_softmax(s_w, m_w)
        o_w = jnp.einsum('bghqk,bkgd->bqghd', p_w.astype(vwin.dtype), vwin)
        return gt[..., 0:1] * o_c + gt[..., 1:2] * o_s + gt[..., 2:3] * o_w

    out = lax.map(query_block, jnp.arange(nq))
    return out.transpose(1, 0, 2, 3, 4, 5).reshape(B, S, G * HG * d)


def _gla(q, k, v, log_a):
    B, S, H, dk = q.shape
    dv = v.shape[-1]
    C = GLA_CHUNK
    nc = S // C
    f = lambda z: z.astype(jnp.float32).reshape(B, nc, C, H, -1).transpose(0, 3, 1, 2, 4)
    q = f(q) * dk ** -0.5
    k = f(k)
    v = f(v)
    b = jnp.cumsum(f(log_a), axis=3)
    b_last = b[:, :, :, -1:, :]
    qg = q * jnp.exp(b)
    kg = k * jnp.exp(-b)
    causal = jnp.tril(jnp.ones((C, C), dtype=bool))
    att = jnp.where(causal, jnp.einsum('bhnid,bhnjd->bhnij', qg, kg), 0.0)
    o_intra = jnp.einsum('bhnij,bhnjv->bhniv', att, v)
    upd = jnp.einsum('bhncd,bhncv->bhndv', k * jnp.exp(b_last - b), v)
    decay = jnp.exp(b_last[:, :, :, 0, :])

    def step(state, inp):
        dec, u = inp
        return dec[..., None] * state + u, state

    _, s_prev = lax.scan(step, jnp.zeros((B, H, dk, dv), jnp.float32),
                         (decay.transpose(2, 0, 1, 3), upd.transpose(2, 0, 1, 3, 4)))
    s_prev = s_prev.transpose(1, 2, 0, 3, 4)
    o = o_intra + jnp.einsum('bhncd,bhndv->bhncv', qg, s_prev)
    return o.transpose(0, 2, 3, 1, 4).reshape(B, S, H, dv)


def _layer(x, cos, sin, g_pre, w_in, cmp_pos_k, cmp_w1_k, cmp_w2_k, cmp_pos_v, cmp_w1_v, cmp_w2_v,
           gla_w_a, gla_b_a, gla_g_norm, w_up_nsa, w_up_gla, w_out, g_post):
    B, S, _ = x.shape
    G, HG, d = NSA_GROUPS, NSA_HEADS_PER_GROUP, HEAD_DIM
    h = _rms(x, g_pre)
    proj = h @ w_in
    offs = np.cumsum(IN_SPLITS)[:-1].tolist()
    (p_q, p_kc, p_vc, p_ks, p_vs, p_kw, p_vw, p_ng, p_nz,
     p_gq, p_gk, p_gv, p_ga, p_gr, p_mg) = jnp.split(proj, offs, axis=-1)
    q = p_q.reshape(B, S, NSA_HEADS, d)
    q_rope = _rope(q, cos, sin).reshape(B, S, G, HG, d)
    q_nope = q.reshape(B, S, G, HG, d)
    k_cmp = _compress(p_kc.reshape(B, S, G, d), cmp_pos_k, cmp_w1_k, cmp_w2_k)
    v_cmp = _compress(p_vc.reshape(B, S, G, d), cmp_pos_v, cmp_w1_v, cmp_w2_v)
    k_slc = _rope(p_ks.reshape(B, S, G, d), cos, sin)
    v_slc = p_vs.reshape(B, S, G, d)
    k_win = _rope(p_kw.reshape(B, S, G, d), cos, sin)
    v_win = p_vw.reshape(B, S, G, d)
    nsa_gate = jax.nn.sigmoid(p_ng).reshape(B, S, G, HG, 3)
    o_nsa = _nsa_attention(q_rope, q_nope, k_cmp, v_cmp, k_slc, v_slc, k_win, v_win, nsa_gate)
    o_nsa = o_nsa * jax.nn.silu(p_nz)
    gq = p_gq.reshape(B, S, GLA_HEADS, GLA_KEY_HEAD)
    gk = p_gk.reshape(B, S, GLA_HEADS, GLA_KEY_HEAD)
    gv = p_gv.reshape(B, S, GLA_HEADS, GLA_VALUE_HEAD)
    a_logit = (p_ga @ gla_w_a + gla_b_a).astype(jnp.float32)
    log_a = (jax.nn.log_sigmoid(a_logit) / GLA_TAU).reshape(B, S, GLA_HEADS, GLA_KEY_HEAD)
    o_gla = _rms(_gla(gq, gk, gv, log_a), gla_g_norm).astype(x.dtype)
    o_gla = (o_gla * jax.nn.silu(p_gr.reshape(B, S, GLA_HEADS, GLA_VALUE_HEAD))).reshape(B, S, GLA_VALUE_DIM)
    m_nsa, m_gla = jnp.split(jax.nn.sigmoid(p_mg), N_BRANCHES, axis=-1)
    y = m_nsa * (o_nsa @ w_up_nsa) + m_gla * (o_gla @ w_up_gla)
    out = y @ w_out
    return x + _rms(out, g_post)


def setup_inputs(seed: int = 0) -> dict:
    key = jax.random.key(seed)
    ks = jax.random.split(key, 16)
    L, D = DEPTH, D_MODEL
    nrm = lambda k, shape, fan_in: jax.random.normal(k, shape, jnp.float32) * fan_in ** -0.5
    small = lambda k, shape, s: s * jax.random.normal(k, shape, jnp.float32)
    return {
        'x': jax.random.normal(ks[0], (BATCH, SEQ, D), jnp.float32),
        'g_pre': 1.0 + small(ks[1], (L, D), 0.01),
        'w_in': nrm(ks[2], (L, D, D_IN), D),
        'cmp_pos_k': small(ks[3], (L, CMP_BLOCK, HEAD_DIM), 0.02),
        'cmp_w1_k': nrm(ks[4], (L, CMP_BLOCK, HEAD_DIM, CMP_HIDDEN), CMP_BLOCK * HEAD_DIM),
        'cmp_w2_k': nrm(ks[5], (L, CMP_HIDDEN, HEAD_DIM), CMP_HIDDEN),
        'cmp_pos_v': small(ks[6], (L, CMP_BLOCK, HEAD_DIM), 0.02),
        'cmp_w1_v': nrm(ks[7], (L, CMP_BLOCK, HEAD_DIM, CMP_HIDDEN), CMP_BLOCK * HEAD_DIM),
        'cmp_w2_v': nrm(ks[8], (L, CMP_HIDDEN, HEAD_DIM), CMP_HIDDEN),
        'gla_w_a': nrm(ks[9], (L, GLA_GATE_RANK, GLA_KEY_DIM), GLA_GATE_RANK),
        'gla_b_a': small(ks[10], (L, GLA_KEY_DIM), 0.1),
        'gla_g_norm': 1.0 + small(ks[11], (L, GLA_VALUE_HEAD), 0.01),
        'w_up_nsa': nrm(ks[12], (L, NSA_WIDTH, D), NSA_WIDTH),
        'w_up_gla': nrm(ks[13], (L, GLA_VALUE_DIM, D), GLA_VALUE_DIM),
        'w_out': nrm(ks[14], (L, D, D), D),
        'g_post': 1.0 + small(ks[15], (L, D), 0.01),
    }


def reference(x, g_pre, w_in, cmp_pos_k, cmp_w1_k, cmp_w2_k, cmp_pos_v, cmp_w1_v, cmp_w2_v,
              gla_w_a, gla_b_a, gla_g_norm, w_up_nsa, w_up_gla, w_out, g_post):
    S = x.shape[1]
    pos = jnp.arange(S, dtype=jnp.float32)
    inv_freq = ROPE_THETA ** (-jnp.arange(0, HEAD_DIM, 2, dtype=jnp.float32) / HEAD_DIM)
    ang = pos[:, None] * inv_freq[None, :]
    cos, sin = jnp.cos(ang), jnp.sin(ang)
    for l in range(DEPTH):
        x = _layer(x, cos, sin, g_pre[l], w_in[l], cmp_pos_k[l], cmp_w1_k[l], cmp_w2_k[l],
                   cmp_pos_v[l], cmp_w1_v[l], cmp_w2_v[l], gla_w_a[l], gla_b_a[l], gla_g_norm[l],
                   w_up_nsa[l], w_up_gla[l], w_out[l], g_post[l])
    return x
```

```cpp
#include <hip/hip_runtime.h>
#include <hip/hip_cooperative_groups.h>
#include <cstdio>
#include <cstdint>
#include <cmath>
namespace cg = cooperative_groups;
namespace pg8 {
#define PG8_LAS __attribute__((address_space(3)))
typedef unsigned short bf16_t;
typedef short bf16x8 __attribute__((ext_vector_type(8)));
typedef float f32x4 __attribute__((ext_vector_type(4)));
typedef unsigned u32x4 __attribute__((ext_vector_type(4)));
constexpr int BM = 256, BK = 64, HALF = 128, HTB = HALF * BK * 2  , STAGE_BYTES = 8 * HTB, NXCD = 8, WGM = 8;

__host__ __device__ __forceinline__ int lds_byte(int r, int c) { const int st = (r >> 4) * 2 + (c >> 5), rr = r & 15, cc = c & 31, ob = rr * 64 + cc * 2; return st * 1024 + (ob ^ (((ob >> 9) & 1) << 5)); }
__host__ __device__ __forceinline__ void stage_rc(int b, int& R, int& C) { const int st = b / 1024, sb = b % 1024, swz = sb ^ (((sb >> 9) & 1) << 5); R = (st >> 1) * 16 + swz / 64; C = (st & 1) * 32 + (swz % 64) / 2; }
__host__ __device__ __forceinline__ int perm32(int rho) { const int n = rho >> 4, i = rho & 15; return 8 * (i >> 2) + 4 * n + (i & 3); }

struct Unit { int pm, pn; };
struct Gemm { const bf16_t* A; const bf16_t* Bt; int M, N, K, lda, ldb; };

struct StaticOrder {
    int nM, nN, nwg, G, c;
    __host__ __device__ void init(int M, int N, int G_, int c_) { nM = M / BM; nN = N / BM; nwg = nM * nN; G = G_; c = c_; }
    __host__ __device__ bool next(int i, Unit& u) const {
        const long L = (long)i * G + c; if (L >= nwg) return false;
        int wgid = (int)L; { const int q = nwg / NXCD, r = nwg % NXCD, xcd = wgid % NXCD, off = wgid / NXCD; wgid = (xcd < r ? xcd * (q + 1) : r * (q + 1) + (xcd - r) * q) + off; }
        const int nig = WGM * nN, gid = wgid / nig, fm = gid * WGM, gsz = (nM - fm) < WGM ? (nM - fm) : WGM;
        u.pm = fm + ((wgid % nig) % gsz); u.pn = (wgid % nig) / gsz; return true;
    }
    __device__ __forceinline__ void a_ready(const Unit&) const {}
    __device__ __forceinline__ void done(const Unit&) const {}
};

__device__ __forceinline__ unsigned cvt_pk_bf16(float lo, float hi) { unsigned r; asm volatile("v_cvt_pk_bf16_f32 %0, %1, %2" : "=v"(r) : "v"(lo), "v"(hi)); return r; }
typedef float f32x2 __attribute__((ext_vector_type(2)));
template <class Epi, class Sched, bool ALIGN_EPI = false, bool SP2 = false>
__device__ __forceinline__ void gemm_phase(PG8_LAS unsigned char* lds, const Gemm g, const Sched& S, const Epi& E) {
    int tid_ = threadIdx.x; asm volatile("" : "+v"(tid_)); const int tid = tid_, wid = __builtin_amdgcn_readfirstlane(tid >> 6), lane = tid & 63, wr = wid >> 2, wc = wid & 3, fr = lane & 15, fq = lane >> 4;
    const int K = g.K, nt = K / BK;
    unsigned voffA[2], voffB[2];
#pragma unroll
    for (int i = 0; i < 2; ++i) { int R, C; stage_rc(tid * 16 + i * 8192, R, C); const int Rb = Epi::PERM ? ((R & ~31) + perm32(R & 31)) : R;
        voffA[i] = (unsigned)(R * g.lda + C) * 2u; voffB[i] = (unsigned)(Rb * g.ldb + C) * 2u; }
    const size_t kstep = (size_t)(BK * 2);
    const size_t hstepA = (size_t)HALF * g.lda * 2, hstepB = (size_t)HALF * g.ldb * 2;
    const size_t tstepA = 2 * hstepA, tstepB = 2 * hstepB;
    const unsigned ldsw = (unsigned)wid * 1024u;
    const int aoff = lds_byte(wr * 64 + fr, fq * 8), boff = lds_byte(wc * 32 + fr, fq * 8);
#define PG8_SA(b, h) (((b) * 2 + (h)) * HTB)
#define PG8_SB(b, h) ((4 + (b) * 2 + (h)) * HTB)
#define PG8_STAGE(bufoff, gbase, voff) do { _Pragma("unroll") for (int _i = 0; _i < 2; ++_i) \
        __builtin_amdgcn_global_load_lds((const unsigned*)((const char*)(gbase) + (voff)[_i]), (PG8_LAS unsigned*)(lds + (bufoff) + ldsw + _i * 8192), 16, 0, 0); } while (0)
#define PG8_LDA(dst, b, h) do { _Pragma("unroll") for (int m = 0; m < 4; ++m) _Pragma("unroll") for (int k = 0; k < 2; ++k) dst[m][k] = *(const PG8_LAS bf16x8*)(lds + PG8_SA(b, h) + aoff + m * 2048 + k * 1024); } while (0)
#define PG8_LDB(dst, b, h) do { _Pragma("unroll") for (int n = 0; n < 2; ++n) _Pragma("unroll") for (int k = 0; k < 2; ++k) dst[n][k] = *(const PG8_LAS bf16x8*)(lds + PG8_SB(b, h) + boff + n * 2048 + k * 1024); } while (0)
#define PG8_MMA(ai, bj, At, Bt) do { __builtin_amdgcn_s_setprio(1); _Pragma("unroll") for (int m = 0; m < 4; ++m) _Pragma("unroll") for (int n = 0; n < 2; ++n) _Pragma("unroll") for (int k = 0; k < 2; ++k) \
        acc[ai][bj][m][n] = __builtin_amdgcn_mfma_f32_16x16x32_bf16(Bt[n][k], At[m][k], acc[ai][bj][m][n], 0, 0, 0); __builtin_amdgcn_s_setprio(0); } while (0)
#define PG8_WAIT_V(n) asm volatile("s_waitcnt vmcnt(" #n ")" ::: "memory")
#define PG8_WAIT_L(n) asm volatile("s_waitcnt lgkmcnt(" #n ")" ::: "memory")
#define PG8_BAR __builtin_amdgcn_s_barrier()
#define PG8_SCHED __builtin_amdgcn_sched_barrier(0)
    Unit cur, nxt; int ui = 0;
    if (!S.next(0, cur)) return;
    f32x4 acc[2][2][4][2];
#pragma unroll
    for (int a = 0; a < 2; ++a)
#pragma unroll
        for (int b = 0; b < 2; ++b)
#pragma unroll
            for (int m = 0; m < 4; ++m)
#pragma unroll
                for (int n = 0; n < 2; ++n) acc[a][b][m][n] = (f32x4){0.f, 0.f, 0.f, 0.f};
    bf16x8 At[4][2], B0[2][2], B1[2][2];
    const char* cA = (const char*)g.A + (size_t)cur.pm * tstepA; const char* cB = (const char*)g.Bt + (size_t)cur.pn * tstepB;
    S.a_ready(cur);
    if constexpr (SP2) {
        PG8_STAGE(PG8_SB(0, 0), cB, voffB); PG8_STAGE(PG8_SB(0, 1), cB + hstepB, voffB); PG8_STAGE(PG8_SA(0, 0), cA, voffA); PG8_STAGE(PG8_SA(0, 1), cA + hstepA, voffA);
        if (wr == 1) PG8_BAR;
        PG8_WAIT_V(2); PG8_BAR;
        PG8_STAGE(PG8_SB(1, 0), cB + kstep, voffB); PG8_STAGE(PG8_SA(1, 0), cA + kstep, voffA); PG8_STAGE(PG8_SB(1, 1), cB + hstepB + kstep, voffB);
        PG8_WAIT_V(6); PG8_BAR;
    } else {
        PG8_STAGE(PG8_SB(0, 0), cB, voffB); PG8_STAGE(PG8_SA(0, 0), cA, voffA); PG8_STAGE(PG8_SB(0, 1), cB + hstepB, voffB); PG8_STAGE(PG8_SA(0, 1), cA + hstepA, voffA);
        if (wr == 1) PG8_BAR;
        PG8_WAIT_V(4); PG8_BAR;
        PG8_STAGE(PG8_SB(1, 0), cB + kstep, voffB); PG8_STAGE(PG8_SA(1, 0), cA + kstep, voffA); PG8_STAGE(PG8_SB(1, 1), cB + hstepB + kstep, voffB);
        PG8_WAIT_V(6); PG8_BAR;
    }
    for (;;) {
        const bool has_next = S.next(ui + 1, nxt);
        const char* nA = has_next ? (const char*)g.A + (size_t)nxt.pm * tstepA : cA; const char* nB = has_next ? (const char*)g.Bt + (size_t)nxt.pn * tstepB : cB;
        for (int t = 0; t < nt; t += 2) {
            const bool last = (t == nt - 2);
            const char* a1 = cA + (size_t)(t + 1) * kstep;
            const char* a2 = last ? nA : cA + (size_t)(t + 2) * kstep; const char* b2 = last ? nB : cB + (size_t)(t + 2) * kstep;
            const char* a3 = a2 + kstep; const char* b3 = b2 + kstep;
            if (last && has_next) S.a_ready(nxt);
            if constexpr (SP2) {
            PG8_LDB(B0, 0, 0); PG8_LDB(B1, 0, 1); PG8_SCHED; PG8_LDA(At, 0, 0); PG8_STAGE(PG8_SA(1, 1), a1 + hstepA, voffA);
            PG8_WAIT_V(8); PG8_WAIT_L(0); PG8_BAR; PG8_MMA(0, 0, At, B0); PG8_MMA(0, 1, At, B1); PG8_BAR; PG8_SCHED;
            PG8_LDA(At, 0, 1); PG8_STAGE(PG8_SB(0, 0), b2, voffB); PG8_STAGE(PG8_SB(0, 1), b2 + hstepB, voffB); PG8_STAGE(PG8_SA(0, 0), a2, voffA);
            PG8_WAIT_V(8); PG8_WAIT_L(0); PG8_BAR; PG8_MMA(1, 0, At, B0); PG8_MMA(1, 1, At, B1); PG8_BAR; PG8_SCHED;
            PG8_LDB(B0, 1, 0); PG8_LDB(B1, 1, 1); PG8_SCHED; PG8_LDA(At, 1, 0); PG8_STAGE(PG8_SA(0, 1), a2 + hstepA, voffA);
            PG8_WAIT_V(8); PG8_WAIT_L(0); PG8_BAR; PG8_MMA(0, 0, At, B0); PG8_MMA(0, 1, At, B1); PG8_BAR; PG8_SCHED;
            PG8_LDA(At, 1, 1); PG8_STAGE(PG8_SB(1, 0), b3, voffB); PG8_STAGE(PG8_SB(1, 1), b3 + hstepB, voffB); PG8_STAGE(PG8_SA(1, 0), a3, voffA);
            PG8_WAIT_V(8); PG8_WAIT_L(0); PG8_BAR; PG8_MMA(1, 0, At, B0); PG8_MMA(1, 1, At, B1); PG8_BAR; PG8_SCHED;
            } else {
            PG8_LDB(B0, 0, 0); PG8_SCHED; PG8_LDA(At, 0, 0); PG8_STAGE(PG8_SA(1, 1), a1 + hstepA, voffA);
            PG8_WAIT_L(8); PG8_BAR; PG8_WAIT_L(0); PG8_MMA(0, 0, At, B0); PG8_BAR; PG8_SCHED;
            PG8_LDB(B1, 0, 1); PG8_STAGE(PG8_SB(0, 0), b2, voffB);
            PG8_BAR; PG8_WAIT_L(0); PG8_MMA(0, 1, At, B1); PG8_BAR;
            PG8_LDA(At, 0, 1); PG8_STAGE(PG8_SA(0, 0), a2, voffA);
            PG8_BAR; PG8_WAIT_L(0); PG8_MMA(1, 0, At, B0); PG8_BAR; PG8_SCHED;
            PG8_STAGE(PG8_SB(0, 1), b2 + hstepB, voffB);
            PG8_WAIT_V(6); PG8_BAR; PG8_MMA(1, 1, At, B1); PG8_BAR;
            PG8_LDB(B0, 1, 0); PG8_SCHED; PG8_LDA(At, 1, 0); PG8_STAGE(PG8_SA(0, 1), a2 + hstepA, voffA);
            PG8_WAIT_L(8); PG8_BAR; PG8_WAIT_L(0); PG8_MMA(0, 0, At, B0); PG8_BAR; PG8_SCHED;
            PG8_LDB(B1, 1, 1); PG8_STAGE(PG8_SB(1, 0), b3, voffB);
            PG8_BAR; PG8_WAIT_L(0); PG8_MMA(0, 1, At, B1); PG8_BAR;
            PG8_LDA(At, 1, 1); PG8_STAGE(PG8_SA(1, 0), a3, voffA);
            PG8_BAR; PG8_WAIT_L(0); PG8_MMA(1, 0, At, B0); PG8_BAR; PG8_SCHED;
            PG8_STAGE(PG8_SB(1, 1), b3 + hstepB, voffB);
            PG8_WAIT_V(6); PG8_BAR; PG8_MMA(1, 1, At, B1); PG8_BAR;
            }
        }
        if constexpr (ALIGN_EPI) { if (wr == 0) PG8_BAR; }
        if constexpr (!Epi::AFTER_DRAIN) { E(acc, cur, wr, wc, fr, fq); S.done(cur); }
        if (!has_next) break;
#pragma unroll
        for (int a = 0; a < 2; ++a)
#pragma unroll
            for (int b = 0; b < 2; ++b)
#pragma unroll
                for (int m = 0; m < 4; ++m)
#pragma unroll
                    for (int n = 0; n < 2; ++n) acc[a][b][m][n] = (f32x4){0.f, 0.f, 0.f, 0.f};
        cur = nxt; cA = nA; cB = nB; ++ui;
        if constexpr (ALIGN_EPI) { if (wr == 1) PG8_BAR; }
    }
    PG8_WAIT_V(0);
    if constexpr (!ALIGN_EPI) { if (wr == 0) PG8_BAR; }
    PG8_BAR;
    if constexpr (Epi::AFTER_DRAIN) { E.fused(acc, cur, wr, wc, fr, fq, lds, wid, lane); S.done(cur); }
#undef PG8_SA
#undef PG8_SB
#undef PG8_STAGE
#undef PG8_LDA
#undef PG8_LDB
#undef PG8_MMA
#undef PG8_WAIT_V
#undef PG8_WAIT_L
#undef PG8_BAR
#undef PG8_SCHED
}
}
#define LAS __attribute__((address_space(3)))
#define DI __device__ __forceinline__
typedef unsigned short bf16;
typedef short bf16x8 __attribute__((ext_vector_type(8)));
typedef short s16x4 __attribute__((ext_vector_type(4)));
typedef float f32x4 __attribute__((ext_vector_type(4)));
typedef float f32x2 __attribute__((ext_vector_type(2)));
typedef float f32x16 __attribute__((ext_vector_type(16)));
typedef unsigned u32x4 __attribute__((ext_vector_type(4)));
typedef unsigned u32x2 __attribute__((ext_vector_type(2)));
typedef __bf16 bf16x2_t __attribute__((ext_vector_type(2)));
typedef short v4i16_t __attribute__((ext_vector_type(4)));

constexpr int NB = 8, SEQ = 4096, T = NB * SEQ, DM = 1024, NPHYS = 5632, DIN = 5416;
constexpr float C2 = 0.125f * 1.4426950408889634f;
constexpr float EPS = 1e-6f;
constexpr float NEGB = -1e30f;
constexpr size_t MiB = 1u << 20;
constexpr size_t O_WIN = 0, O_WUPN = 22 * MiB, O_WUPG = 24 * MiB, O_WOUT = 26 * MiB, O_WC1 = 30 * MiB, O_TAB = 34 * MiB, O_CBIAS = 35 * MiB,
    O_HB = 36 * MiB, O_QN = 100 * MiB, O_KS = 132 * MiB, O_KW = 140 * MiB, O_VS = 148 * MiB, O_VW = 156 * MiB, O_KCRAW = 164 * MiB, O_NZ = 181 * MiB,
    O_GQ = 213 * MiB, O_GK = 229 * MiB, O_GV = 245 * MiB, O_GR = 277 * MiB, O_MG = 309 * MiB, O_MISC = 437 * MiB, O_KCMP = 441 * MiB, O_UPD = 442 * MiB,
    O_DECAY = 506 * MiB, WS_END = 507 * MiB;
constexpr size_t O_Y = O_HB, O_OINTRA = O_HB, O_QG = O_HB + 32 * MiB, O_CPART = O_HB + 48 * MiB;
constexpr size_t O_ONSA = O_GQ, O_OGLA = O_GV, O_OUTB = O_GQ;
constexpr int KCR_ROWS = T + 64;
constexpr int LDS_BYTES = 139264;

#define LDS_WAIT() asm volatile("s_waitcnt lgkmcnt(0)" ::: "memory")
DI unsigned cvtpk(float lo, float hi) { f32x2 v = {lo, hi}; bf16x2_t b = __builtin_convertvector(v, bf16x2_t); return __builtin_bit_cast(unsigned, b); }
DI float bflo(unsigned w) { return __uint_as_float(w << 16); }
DI float bfhi(unsigned w) { return __uint_as_float(w & 0xffff0000u); }
DI float bf2f(bf16 b) { return __uint_as_float(((unsigned)b) << 16); }
DI float sigmoidf_(float x) { return 1.f / (1.f + __expf(-x)); }
DI float siluf_(float x) { return x / (1.f + __expf(-x)); }
DI float wave_sum(float v) {
#pragma unroll
    for (int o = 1; o < 64; o <<= 1) v += __shfl_xor(v, o);
    return v;
}
DI int crow(int reg, int hi) { return (reg & 3) + 8 * (reg >> 2) + 4 * hi; }
#define MFMA32(a, b, c) __builtin_amdgcn_mfma_f32_32x32x16_bf16((a), (b), (c), 0, 0, 0)
DI s16x4 vtr(const LAS unsigned char* p) { return __builtin_bit_cast(s16x4, __builtin_amdgcn_ds_read_tr16_b64_v4i16((LAS v4i16_t*)p)); }
DI bf16x8 cat8(s16x4 lo, s16x4 hi) { return __builtin_shufflevector(lo, hi, 0, 1, 2, 3, 4, 5, 6, 7); }
DI bf16x8 pack8(float a0, float a1, float a2, float a3, float a4, float a5, float a6, float a7) {
    u32x4 w; w.x = cvtpk(a0, a1); w.y = cvtpk(a2, a3); w.z = cvtpk(a4, a5); w.w = cvtpk(a6, a7); return __builtin_bit_cast(bf16x8, w);
}

struct Args { const float* in[16]; float* out; unsigned char* ws; };
struct Ctx {
    const Args* a;
    float* out;
    unsigned char* ws;
    int tid, lane, wid, G, vcu;
};
DI Ctx launder(const Ctx& c0) { Ctx c = c0; asm volatile("" : "+s"(c.ws), "+s"(c.out), "+v"(c.tid)); return c; }
enum { I_X = 0, I_GPRE, I_WIN, I_CPK, I_CW1K, I_CW2K, I_CPV, I_CW1V, I_CW2V, I_GWA, I_GBA, I_GNORM, I_WUPN, I_WUPG, I_WOUT, I_GPOST };

DI void map_block(int pb, int& src0, int& nvalid) {
    const int tile = pb >> 3, blk = pb & 7; nvalid = 32;
    if (tile <= 1) src0 = tile * 256 + blk * 32;
    else if (tile == 2) { const int bj = blk >> 2, hh = blk & 3; src0 = (hh < 2 ? 768 + hh * 64 : 1024 + (hh - 2) * 64) + 32 * bj; }
    else if (tile == 3) src0 = blk < 4 ? 512 + 32 * blk : 640 + 32 * (blk - 4);
    else if (tile == 4) src0 = blk < 4 ? 896 + 32 * blk : 1152 + 32 * (blk - 4);
    else if (tile <= 6) src0 = 1304 + (tile - 5) * 256 + 32 * blk;
    else if (tile == 7) src0 = 1816 + 32 * blk;
    else if (tile == 8) src0 = 2072 + 32 * blk;
    else if (tile <= 10) src0 = 2328 + (tile - 9) * 256 + 32 * blk;
    else if (tile <= 12) src0 = 2856 + (tile - 11) * 256 + 32 * blk;
    else if (tile <= 20) src0 = 3368 + (tile - 13) * 256 + 32 * blk;
    else { if (blk == 0) { src0 = 1280; nvalid = 24; } else if (blk == 1) { src0 = 2840; nvalid = 16; } else { src0 = 0; nvalid = 0; } }
}
DI void transpose_item(const float* W, int ldw, int src0, int nvalid, int ldk, bf16* WT, int dst_row0, LAS float* scr, int kb, int lane) {
    const int k0 = 64 * kb, n = lane & 31;
    float tv[32];
#pragma unroll
    for (int i = 0; i < 32; ++i) { const int kk = 2 * i + (lane >> 5); tv[i] = 0.f; if (n < nvalid) tv[i] = W[(size_t)(k0 + kk) * ldw + src0 + n]; }
#pragma unroll
    for (int i = 0; i < 32; ++i) { const int kk = 2 * i + (lane >> 5); scr[kk * 33 + n] = tv[i]; }
    LDS_WAIT();
    const int c = lane & 7;
#pragma unroll
    for (int j = 0; j < 4; ++j) { const int nn = (lane >> 3) + 8 * j; const LAS float* s = scr + (8 * c) * 33 + nn;
        u32x4 o; o.x = cvtpk(s[0 * 33], s[1 * 33]); o.y = cvtpk(s[2 * 33], s[3 * 33]); o.z = cvtpk(s[4 * 33], s[5 * 33]); o.w = cvtpk(s[6 * 33], s[7 * 33]);
        *(u32x4*)(WT + (size_t)(dst_row0 + nn) * ldk + k0 + 8 * c) = o; }
    LDS_WAIT();
}
DI void rms_row_bf16(const float* xrow, const float* g, bf16* orow, int lane) {
    f32x4 v[4]; float s = 0.f;
#pragma unroll
    for (int j = 0; j < 4; ++j) { v[j] = ((const f32x4*)xrow)[lane + 64 * j]; s += (v[j].x * v[j].x + v[j].y * v[j].y) + (v[j].z * v[j].z + v[j].w * v[j].w); }
    const float r = 1.f / sqrtf(wave_sum(s) * (1.f / 1024.f) + EPS);
#pragma unroll
    for (int j = 0; j < 4; ++j) { const f32x4 gg = ((const f32x4*)g)[lane + 64 * j]; u32x2 o; o.x = cvtpk(v[j].x * r * gg.x, v[j].y * r * gg.y); o.y = cvtpk(v[j].z * r * gg.z, v[j].w * r * gg.w);
        ((u32x2*)orow)[lane + 64 * j] = o; }
}
DI void phase0(const Ctx& c0, LAS unsigned char* lds) {
    const Ctx c = launder(c0);
    LAS float* scr = (LAS float*)(lds + c.wid * 16384);
    const int gw = blockIdx.x * 8 + c.wid, NGW = c.G * 8;
    constexpr int PER_L = 2816 + 256 + 256 + 512 + 256 + 256;
    for (int it = gw; it < 2 * PER_L; it += NGW) {
        const int l = it / PER_L; int r = it % PER_L;
        if (r < 2816) { const int pb = r >> 4, kb = r & 15; int src0, nv; map_block(pb, src0, nv);
            transpose_item(c.a->in[I_WIN] + (size_t)l * 1024 * DIN, DIN, src0, nv, 1024, (bf16*)(c.ws + O_WIN + (size_t)l * 11 * MiB), pb * 32, scr, kb, c.lane); continue; }
        r -= 2816;
        if (r < 256) { transpose_item(c.a->in[I_WUPN] + (size_t)l * 512 * 1024, 1024, (r & 31) * 32, 32, 512, (bf16*)(c.ws + O_WUPN + (size_t)l * MiB), (r & 31) * 32, scr, r >> 5, c.lane); continue; }
        r -= 256;
        if (r < 256) { transpose_item(c.a->in[I_WUPG] + (size_t)l * 512 * 1024, 1024, (r & 31) * 32, 32, 512, (bf16*)(c.ws + O_WUPG + (size_t)l * MiB), (r & 31) * 32, scr, r >> 5, c.lane); continue; }
        r -= 256;
        if (r < 512) { transpose_item(c.a->in[I_WOUT] + (size_t)l * 1024 * 1024, 1024, (r & 31) * 32, 32, 1024, (bf16*)(c.ws + O_WOUT + (size_t)l * 2 * MiB), (r & 31) * 32, scr, r >> 5, c.lane); continue; }
        r -= 512;
        { const int kv = r >> 8; r &= 255; const int nb = r & 7, kb = r >> 3;
          transpose_item(c.a->in[kv ? I_CW1V : I_CW1K] + (size_t)l * 2048 * 128, 128, (nb & 3) * 32, nb < 4 ? 32 : 0, 2048, (bf16*)(c.ws + O_WC1 + (size_t)(l * 2 + kv) * MiB), nb * 32, scr, kb, c.lane); }
    }
    { float* ct = (float*)(c.ws + O_TAB); float* st = ct + 4096 * 32;
      for (int i = blockIdx.x * 512 + c.tid; i < 4096 * 32; i += c.G * 512) { const int pos = i >> 5, e = i & 31;
          const float inv = (float)pow(10000.0, -(double)e / 32.0); const float ang = (float)pos * inv;
          const double a = (double)ang; const double k = rint(a * 0.15915494309189535); const double rr = a - k * 6.283185307179586;
          ct[i] = cosf((float)rr); st[i] = sinf((float)rr); } }
    { float* cb = (float*)(c.ws + O_CBIAS);
      for (int o = gw; o < 512; o += NGW) { const int l = o >> 8, kv = (o >> 7) & 1, h = o & 127;
          const float* pos = c.a->in[kv ? I_CPV : I_CPK] + (size_t)l * 2048; const float* w1 = c.a->in[kv ? I_CW1V : I_CW1K] + (size_t)l * 2048 * 128;
          float s = 0.f;
          for (int i = 0; i < 32; ++i) { const int ld = c.lane + 64 * i; s += pos[ld] * w1[(size_t)ld * 128 + h]; }
          s = wave_sum(s); if (c.lane == 0) cb[o] = s; } }
    for (int m = gw; m < T; m += NGW) rms_row_bf16(c.a->in[I_X] + (size_t)m * DM, c.a->in[I_GPRE], (bf16*)(c.ws + O_HB) + (size_t)m * DM, c.lane);
}

struct EpiProj {
    static constexpr bool PERM = true, AFTER_DRAIN = false;
    unsigned char* ws;
    DI void operator()(const pg8::f32x4 (&acc)[2][2][4][2], const pg8::Unit& u, int wr, int wc, int fr, int fq) const {
        const int pn = u.pn; const int row0 = u.pm * 256 + wr * 64 + fr;
        if (pn == 2) {
            const float* ct = (const float*)(ws + O_TAB); const float* st = ct + 4096 * 32;
            bf16* dst = (bf16*)(ws + O_KS) + (size_t)wc * T * 64;
#pragma unroll
            for (int ai = 0; ai < 2; ++ai)
#pragma unroll
                for (int m = 0; m < 4; ++m) { const int row = row0 + ai * 128 + m * 16; const int pos = row & (SEQ - 1);
                    const f32x4 c0 = *(const f32x4*)(ct + pos * 32 + 8 * fq), c1 = *(const f32x4*)(ct + pos * 32 + 8 * fq + 4);
                    const f32x4 s0 = *(const f32x4*)(st + pos * 32 + 8 * fq), s1 = *(const f32x4*)(st + pos * 32 + 8 * fq + 4);
                    const f32x4 l0 = acc[ai][0][m][0], l1 = acc[ai][0][m][1], h0 = acc[ai][1][m][0], h1 = acc[ai][1][m][1];
                    const f32x4 ol0 = l0 * c0 - h0 * s0, ol1 = l1 * c1 - h1 * s1, oh0 = h0 * c0 + l0 * s0, oh1 = h1 * c1 + l1 * s1;
                    u32x4 w; w.x = cvtpk(ol0[0], ol0[1]); w.y = cvtpk(ol0[2], ol0[3]); w.z = cvtpk(ol1[0], ol1[1]); w.w = cvtpk(ol1[2], ol1[3]);
                    *(u32x4*)(dst + (size_t)row * 64 + 8 * fq) = w;
                    w.x = cvtpk(oh0[0], oh0[1]); w.y = cvtpk(oh0[2], oh0[3]); w.z = cvtpk(oh1[0], oh1[1]); w.w = cvtpk(oh1[2], oh1[3]);
                    *(u32x4*)(dst + (size_t)row * 64 + 32 + 8 * fq) = w; }
            return;
        }
        bf16* base; int ld; size_t gs = 64; float sc = 1.f;
        if (pn <= 1) { base = (bf16*)(ws + O_QN) + pn * 256; ld = 512; sc = C2; }
        else if (pn == 3) { base = (bf16*)(ws + O_KCRAW); ld = 64; gs = (size_t)KCR_ROWS * 64; }
        else if (pn == 4) { base = (bf16*)(ws + O_VS); ld = 64; gs = (size_t)T * 64; }
        else if (pn <= 6) { base = (bf16*)(ws + O_NZ) + (pn - 5) * 256; ld = 512; }
        else if (pn == 7) { base = (bf16*)(ws + O_GQ); ld = 256; }
        else if (pn == 8) { base = (bf16*)(ws + O_GK); ld = 256; }
        else if (pn <= 10) { base = (bf16*)(ws + O_GV) + (pn - 9) * 256; ld = 512; }
        else if (pn <= 12) { base = (bf16*)(ws + O_GR) + (pn - 11) * 256; ld = 512; }
        else if (pn <= 20) { base = (bf16*)(ws + O_MG) + (pn - 13) * 256; ld = 2048; }
        else { base = (bf16*)(ws + O_MISC); ld = 64; }
#pragma unroll
        for (int bj = 0; bj < 2; ++bj) {
            const int col = 128 * bj + 32 * wc + 8 * fq; const int grp = col >> 6, cin = col & 63;
            if (pn == 21 && grp > 0) continue;
            bf16* bp = base + (size_t)grp * gs + cin;
#pragma unroll
            for (int ai = 0; ai < 2; ++ai)
#pragma unroll
                for (int m = 0; m < 4; ++m) { const int row = row0 + ai * 128 + m * 16;
                    const f32x4 v0 = acc[ai][bj][m][0] * sc, v1 = acc[ai][bj][m][1] * sc;
                    u32x4 w; w.x = cvtpk(v0[0], v0[1]); w.y = cvtpk(v0[2], v0[3]); w.z = cvtpk(v1[0], v1[1]); w.w = cvtpk(v1[2], v1[3]);
                    *(u32x4*)(bp + (size_t)row * ld) = w; }
        }
    }
};
struct EpiCPart {
    static constexpr bool PERM = false, AFTER_DRAIN = false;
    float* dst;
    DI void operator()(const pg8::f32x4 (&acc)[2][2][4][2], const pg8::Unit& u, int wr, int wc, int fr, int fq) const {
        const int row0 = u.pm * 256 + wr * 64 + fr;
#pragma unroll
        for (int ai = 0; ai < 2; ++ai)
#pragma unroll
            for (int m = 0; m < 4; ++m) { const int row = row0 + ai * 128 + m * 16;
#pragma unroll
                for (int n = 0; n < 2; ++n) *(f32x4*)(dst + (size_t)row * 128 + 32 * wc + 16 * n + 4 * fq) = acc[ai][0][m][n]; }
    }
};
template <bool ADD> struct EpiUp {
    static constexpr bool PERM = true, AFTER_DRAIN = false;
    const bf16* mg; bf16* y;
    DI void operator()(const pg8::f32x4 (&acc)[2][2][4][2], const pg8::Unit& u, int wr, int wc, int fr, int fq) const {
        const int row0 = u.pm * 256 + wr * 64 + fr;
#pragma unroll
        for (int bj = 0; bj < 2; ++bj) { const int col = u.pn * 256 + 128 * bj + 32 * wc + 8 * fq;
#pragma unroll
            for (int ai = 0; ai < 2; ++ai)
#pragma unroll
                for (int m = 0; m < 4; ++m) { const int row = row0 + ai * 128 + m * 16;
                    const u32x4 g = *(const u32x4*)(mg + (size_t)row * 2048 + col);
                    const f32x4 a0 = acc[ai][bj][m][0], a1 = acc[ai][bj][m][1];
                    float v[8];
                    v[0] = sigmoidf_(bflo(g.x)) * a0[0]; v[1] = sigmoidf_(bfhi(g.x)) * a0[1]; v[2] = sigmoidf_(bflo(g.y)) * a0[2]; v[3] = sigmoidf_(bfhi(g.y)) * a0[3];
                    v[4] = sigmoidf_(bflo(g.z)) * a1[0]; v[5] = sigmoidf_(bfhi(g.z)) * a1[1]; v[6] = sigmoidf_(bflo(g.w)) * a1[2]; v[7] = sigmoidf_(bfhi(g.w)) * a1[3];
                    u32x4* yp = (u32x4*)(y + (size_t)row * 1024 + col);
                    if (ADD) { const u32x4 o = *yp; v[0] += bflo(o.x); v[1] += bfhi(o.x); v[2] += bflo(o.y); v[3] += bfhi(o.y); v[4] += bflo(o.z); v[5] += bfhi(o.z); v[6] += bflo(o.w); v[7] += bfhi(o.w); }
                    u32x4 w; w.x = cvtpk(v[0], v[1]); w.y = cvtpk(v[2], v[3]); w.z = cvtpk(v[4], v[5]); w.w = cvtpk(v[6], v[7]);
                    *yp = w; }
        }
    }
};
struct EpiPlain {
    static constexpr bool PERM = true, AFTER_DRAIN = false;
    bf16* O; int ldc;
    DI void operator()(const pg8::f32x4 (&acc)[2][2][4][2], const pg8::Unit& u, int wr, int wc, int fr, int fq) const {
        const int row0 = u.pm * 256 + wr * 64 + fr;
#pragma unroll
        for (int bj = 0; bj < 2; ++bj) { const int col = u.pn * 256 + 128 * bj + 32 * wc + 8 * fq;
#pragma unroll
            for (int ai = 0; ai < 2; ++ai)
#pragma unroll
                for (int m = 0; m < 4; ++m) { const int row = row0 + ai * 128 + m * 16;
                    const f32x4 v0 = acc[ai][bj][m][0], v1 = acc[ai][bj][m][1];
                    u32x4 w; w.x = cvtpk(v0[0], v0[1]); w.y = cvtpk(v0[2], v0[3]); w.z = cvtpk(v1[0], v1[1]); w.w = cvtpk(v1[2], v1[3]);
                    *(u32x4*)(O + (size_t)row * ldc + col) = w; }
        }
    }
};
struct OneUnit {
    int pm; bool has;
    DI bool next(int i, pg8::Unit& u) const { if (i > 0 || !has) return false; u.pm = pm; u.pn = 0; return true; }
    DI void a_ready(const pg8::Unit&) const {}
    DI void done(const pg8::Unit&) const {}
};
#define XB_TMO      128
#define XB_XCNT(j)  (256  + 64 * (j))
#define XB_XSUB(j)  (1280 + 64 * (j))
#define XB_XGEN(j)  (2304 + 64 * (j))
#define XB_TOP      3328
#define XB_TOPGEN   3392
#define XCD_BAR_WORDS 3456
#define XB_SPIN_CAP (1u << 18)

__device__ __forceinline__ unsigned xb_ld(unsigned* p)              { return __hip_atomic_load(p, __ATOMIC_RELAXED, __HIP_MEMORY_SCOPE_AGENT); }
__device__ __forceinline__ unsigned xb_add(unsigned* p, unsigned v) { return __hip_atomic_fetch_add(p, v, __ATOMIC_RELAXED, __HIP_MEMORY_SCOPE_AGENT); }
__device__ __forceinline__ unsigned xb_xcc_id() { return (unsigned)__builtin_amdgcn_s_getreg((3 << 11) | 20) & 0xFu; }
#define XB_SPIN(cond, bar) do { unsigned _sp = 0; while (cond) { __builtin_amdgcn_s_sleep(1); \
    if ((++_sp & 255u) == 0u) { if (xb_ld(&(bar)[XB_TMO])) break; if (_sp > XB_SPIN_CAP) { atomicAdd(&(bar)[XB_TMO], 1u); break; } } } } while (0)

struct XcdBarrier {
    unsigned* bar; unsigned x;
    volatile LAS unsigned* st;
};

__device__ __forceinline__ XcdBarrier xcd_barrier_post(unsigned* bar, volatile LAS unsigned* st) {
    XcdBarrier b; b.bar = bar; b.x = xb_xcc_id(); b.st = st;
    if (threadIdx.x == 0) (void)xb_add(&bar[XB_XCNT(b.x)], 1u);
    return b;
}
__device__ __forceinline__ void xcd_barrier_complete(unsigned* bar, unsigned x, unsigned& nloc, unsigned& nx) {
    const unsigned G = gridDim.x * gridDim.y * gridDim.z;
    unsigned sum, cnt, mine, sp = 0u;
    for (;;) {
        sum = 0u; cnt = 0u; mine = 0u;
#pragma unroll
        for (unsigned j = 0; j < 16; ++j) { const unsigned c = xb_ld(&bar[XB_XCNT(j)]); sum += c; cnt += (c > 0u) ? 1u : 0u; mine = (j == x) ? c : mine; }
        if (sum == G) break;
        __builtin_amdgcn_s_sleep(1);
        if ((++sp & 255u) == 0u) { if (xb_ld(&bar[XB_TMO])) break; if (sp > XB_SPIN_CAP) { atomicAdd(&bar[XB_TMO], 1u); break; } }
    }
    nloc = mine > 0u ? mine : 1u; nx = cnt > 0u ? cnt : 1u;
}

__device__ __forceinline__ void xcd_barrier(const XcdBarrier& b) {
    asm volatile("s_waitcnt vmcnt(0)" ::: "memory");
    __syncthreads();
    if (threadIdx.x == 0) {
        unsigned* bar = b.bar;
        __builtin_amdgcn_s_waitcnt(0);
        unsigned nloc = b.st[0], nx = b.st[1];
        if (nloc == 0u) { xcd_barrier_complete(bar, b.x, nloc, nx); b.st[0] = nloc; b.st[1] = nx; }
        const unsigned old = xb_add(&bar[XB_XSUB(b.x)], 1u);
        const unsigned gen = old / nloc;
        if (old + 1u == (gen + 1u) * nloc) {
            __builtin_amdgcn_fence(__ATOMIC_RELEASE, "agent");
            asm volatile("s_waitcnt vmcnt(0)" ::: "memory");
            const unsigned og = xb_add(&bar[XB_TOP], 1u);
            const unsigned tg = og / nx;
            if (og + 1u == (tg + 1u) * nx) xb_add(&bar[XB_TOPGEN], 1u);
            else XB_SPIN(xb_ld(&bar[XB_TOPGEN]) == tg, bar);
            __builtin_amdgcn_fence(__ATOMIC_ACQUIRE, "agent");
            xb_add(&bar[XB_XGEN(b.x)], 1u);
            asm volatile("s_waitcnt vmcnt(0)" ::: "memory");
        } else {
            XB_SPIN(xb_ld(&bar[XB_XGEN(b.x)]) == gen, bar);
            __builtin_amdgcn_fence(__ATOMIC_ACQUIRE, "agent");
            asm volatile("s_waitcnt vmcnt(0)" ::: "memory");
        }
    }
    __syncthreads();
}
constexpr int G1_LA = 0, G1_PART = 16640, G1_QGT = 18688, G1_KGT = G1_QGT + 8192, G1_KU = G1_KGT + 8192, G1_VI = G1_KU + 8192, G1_END = G1_VI + 16384;
DI void gla_stage1(const Ctx& c0, int layer, int unit, LAS unsigned char* lds) {
    const Ctx c = launder(c0);
    const int tid = c.tid, lane = c.lane, wid = c.wid, r = lane & 31, hi = lane >> 5;
    const int bh = unit >> 6, n = unit & 63, b = bh >> 2, h = bh & 3;
    const size_t row0 = (size_t)b * SEQ + n * 64;
    LAS float* LA = (LAS float*)(lds + G1_LA); LAS float* PART = (LAS float*)(lds + G1_PART);
    const bf16* gq = (const bf16*)(c.ws + O_GQ); const bf16* gk = (const bf16*)(c.ws + O_GK); const bf16* gv = (const bf16*)(c.ws + O_GV);
    const bf16* misc = (const bf16*)(c.ws + O_MISC);
    const float* Wa = c.a->in[I_GWA] + (size_t)layer * 16 * 256 + h * 64; const float* ba = c.a->in[I_GBA] + (size_t)layer * 256 + h * 64;
    const int cc = tid >> 3, ch = tid & 7;
#pragma unroll
    for (int it = 0; it < 2; ++it) { const int idx = tid + 512 * it, vc_ = idx & 15, c_ = idx >> 4;
        const u32x4 v = *(const u32x4*)(gv + (row0 + c_) * 512 + h * 128 + vc_ * 8);
        *(LAS u32x4*)(lds + G1_VI + (vc_ >> 2) * 4096 + c_ * 64 + (vc_ & 3) * 16) = v; }
    {
        float ga[16];
        { const u32x4 g0 = *(const u32x4*)(misc + (row0 + cc) * 64 + 32), g1 = *(const u32x4*)(misc + (row0 + cc) * 64 + 40);
          ga[0] = bflo(g0.x); ga[1] = bfhi(g0.x); ga[2] = bflo(g0.y); ga[3] = bfhi(g0.y); ga[4] = bflo(g0.z); ga[5] = bfhi(g0.z); ga[6] = bflo(g0.w); ga[7] = bfhi(g0.w);
          ga[8] = bflo(g1.x); ga[9] = bfhi(g1.x); ga[10] = bflo(g1.y); ga[11] = bfhi(g1.y); ga[12] = bflo(g1.z); ga[13] = bfhi(g1.z); ga[14] = bflo(g1.w); ga[15] = bfhi(g1.w); }
        f32x4 a0 = *(const f32x4*)(ba + 8 * ch), a1 = *(const f32x4*)(ba + 8 * ch + 4);
        const float* wap = Wa + 8 * ch; asm volatile("" : "+v"(wap));
#pragma unroll
        for (int rr = 0; rr < 16; ++rr) { const f32x4 w0 = *(const f32x4*)(wap + rr * 256), w1 = *(const f32x4*)(wap + rr * 256 + 4); a0 += w0 * ga[rr]; a1 += w1 * ga[rr]; }
#pragma unroll
        for (int j = 0; j < 8; ++j) { const float x = j < 4 ? a0[j & 3] : a1[j & 3];
            const float ls = fminf(x, 0.f) - __logf(1.f + __expf(-fabsf(x)));
            LA[cc * 65 + 8 * ch + j] = ls * (1.f / 16.f); }
    }
    __syncthreads();
    {
        const int d = tid & 63, part = tid >> 6; float v[8]; float run = 0.f;
#pragma unroll
        for (int j = 0; j < 8; ++j) { run += LA[(8 * part + j) * 65 + d]; v[j] = run; }
        PART[part * 64 + d] = run;
        __syncthreads();
        float off = 0.f;
#pragma unroll
        for (int p = 0; p < 8; ++p) off += (p < part) ? PART[p * 64 + d] : 0.f;
#pragma unroll
        for (int j = 0; j < 8; ++j) LA[(8 * part + j) * 65 + d] = v[j] + off;
    }
    __syncthreads();
    {
        const u32x4 qw = *(const u32x4*)(gq + (row0 + cc) * 256 + h * 64 + 8 * ch), kw = *(const u32x4*)(gk + (row0 + cc) * 256 + h * 64 + 8 * ch);
        float q[8], k[8];
        q[0] = bflo(qw.x); q[1] = bfhi(qw.x); q[2] = bflo(qw.y); q[3] = bfhi(qw.y); q[4] = bflo(qw.z); q[5] = bfhi(qw.z); q[6] = bflo(qw.w); q[7] = bfhi(qw.w);
        k[0] = bflo(kw.x); k[1] = bfhi(kw.x); k[2] = bflo(kw.y); k[3] = bfhi(kw.y); k[4] = bflo(kw.z); k[5] = bfhi(kw.z); k[6] = bflo(kw.w); k[7] = bfhi(kw.w);
        float qg[8], kg[8], ku[8];
#pragma unroll
        for (int j = 0; j < 8; ++j) { const float bb = LA[cc * 65 + 8 * ch + j], bl = LA[63 * 65 + 8 * ch + j];
            const float en = __expf(-bb); qg[j] = q[j] * 0.125f * __expf(bb); kg[j] = k[j] * en; ku[j] = k[j] * __expf(bl - bb); }
        const bf16x8 qv = pack8(qg[0], qg[1], qg[2], qg[3], qg[4], qg[5], qg[6], qg[7]);
        *(LAS bf16x8*)(lds + G1_QGT + ch * 1024 + cc * 16) = qv;
        *(bf16x8*)((bf16*)(c.ws + O_QG) + (row0 + cc) * 256 + h * 64 + 8 * ch) = qv;
        *(LAS bf16x8*)(lds + G1_KGT + ch * 1024 + cc * 16) = pack8(kg[0], kg[1], kg[2], kg[3], kg[4], kg[5], kg[6], kg[7]);
        *(LAS bf16x8*)(lds + G1_KU + (ch >> 2) * 4096 + cc * 64 + (ch & 3) * 16) = pack8(ku[0], ku[1], ku[2], ku[3], ku[4], ku[5], ku[6], ku[7]);
        if (tid < 64) ((float*)(c.ws + O_DECAY))[(size_t)unit * 64 + tid] = __expf(LA[63 * 65 + tid]);
    }
    __syncthreads();
    {
        const int cb = wid & 1, vb = wid >> 1;
        const LAS unsigned char* kb = lds + G1_KGT + hi * 1024 + r * 16;
        const LAS unsigned char* qb = lds + G1_QGT + hi * 1024 + (r + 32 * cb) * 16;
        bf16x8 qf[4];
#pragma unroll
        for (int s = 0; s < 4; ++s) qf[s] = *(const LAS bf16x8*)(qb + s * 2048);
        const int cl = 32 * cb + r;
        bf16x8 pa[4];
#pragma unroll
        for (int jb = 0; jb < 2; ++jb) {
            f32x16 x = {};
            if (jb <= cb) {
#pragma unroll
                for (int s = 0; s < 4; ++s) { const bf16x8 a = *(const LAS bf16x8*)(kb + s * 2048 + jb * 512); x = MFMA32(a, qf[s], x); }
#pragma unroll
                for (int rg = 0; rg < 16; ++rg) { const int j = 32 * jb + crow(rg, hi); if (j > cl) x[rg] = 0.f; }
            }
            pa[2 * jb] = pack8(x[0], x[1], x[2], x[3], x[4], x[5], x[6], x[7]);
            pa[2 * jb + 1] = pack8(x[8], x[9], x[10], x[11], x[12], x[13], x[14], x[15]);
        }
        const int troff = (4 * hi + ((lane & 15) >> 2)) * 64 + ((lane >> 4) & 1) * 32 + (lane & 3) * 8;
        const LAS unsigned char* vbp = lds + G1_VI + vb * 4096 + troff;
        const LAS unsigned char* kup = lds + G1_KU + cb * 4096 + troff;
        f32x16 o = {}, uacc = {};
#pragma unroll
        for (int s = 0; s < 4; ++s) {
            const bf16x8 vf = cat8(vtr(vbp + s * 1024), vtr(vbp + s * 1024 + 512));
            const bf16x8 kf = cat8(vtr(kup + s * 1024), vtr(kup + s * 1024 + 512));
            o = MFMA32(pa[s], vf, o);
            uacc = MFMA32(kf, vf, uacc);
        }
        LAS unsigned char* S1 = lds + 65536 + wid * 2048;
        float* upp = (float*)(c.ws + O_UPD) + (size_t)unit * 8192 + (32 * cb + 4 * hi) * 128 + 32 * vb + r; asm volatile("" : "+v"(upp));
#pragma unroll
        for (int rg = 0; rg < 16; ++rg) { const int ro = (rg & 3) + 8 * (rg >> 2);
            *(LAS bf16*)(S1 + (ro + 4 * hi) * 64 + r * 2) = (bf16)(cvtpk(o[rg], 0.f) & 0xffffu);
            upp[ro * 128] = uacc[rg]; }
        LDS_WAIT();
        { bf16* oib = (bf16*)(c.ws + O_OINTRA) + (row0 + 32 * cb) * 512 + h * 128 + 32 * vb;
#pragma unroll
          for (int it = 0; it < 2; ++it) { const int cidx = lane + 64 * it, rw = cidx >> 2, chn = cidx & 3;
              *(u32x4*)(oib + (size_t)rw * 512 + chn * 8) = *(const LAS u32x4*)(S1 + rw * 64 + chn * 16); } }
        LDS_WAIT();
    }
    __syncthreads();
}
DI void gla_stage2(const Ctx& c) {
    float* upd = (float*)(c.ws + O_UPD); const float* dec = (const float*)(c.ws + O_DECAY);
    for (int e = blockIdx.x * 512 + c.tid; e < 32 * 4096; e += c.G * 512) {
        const int bh = e >> 12, pp = e & 4095, d = pp >> 6, v2 = (pp & 63) * 2;
        float* p = upd + (size_t)bh * 64 * 8192 + d * 128 + v2; const float* dp = dec + (size_t)bh * 64 * 64 + d;
        float s0 = 0.f, s1 = 0.f;
        for (int n0 = 0; n0 < 64; n0 += 16) {
            f32x2 u[16]; float dd[16];
#pragma unroll
            for (int j = 0; j < 16; ++j) { u[j] = *(const f32x2*)(p + (size_t)(n0 + j) * 8192); dd[j] = dp[(n0 + j) * 64]; }
#pragma unroll
            for (int j = 0; j < 16; ++j) { *(f32x2*)(p + (size_t)(n0 + j) * 8192) = (f32x2){s0, s1}; s0 = dd[j] * s0 + u[j].x; s1 = dd[j] * s1 + u[j].y; }
        }
    }
}
constexpr int G3_PITCH = 272, G3_BYTES = 32 * G3_PITCH;
DI void g3_tile_in(const bf16* g, LAS unsigned char* R, int lane) {
#pragma unroll
    for (int it = 0; it < 8; ++it) { const int row = 4 * it + (lane >> 4), ch = lane & 15;
        *(LAS u32x4*)(R + row * G3_PITCH + ch * 16) = *(const u32x4*)(g + (size_t)row * 512 + ch * 8); }
    LDS_WAIT();
}
DI void g3_tile_out(bf16* g, const LAS unsigned char* R, int lane) {
    LDS_WAIT();
#pragma unroll
    for (int it = 0; it < 8; ++it) { const int row = 4 * it + (lane >> 4), ch = lane & 15;
        *(u32x4*)(g + (size_t)row * 512 + ch * 8) = *(const LAS u32x4*)(R + row * G3_PITCH + ch * 16); }
    LDS_WAIT();
}
DI void gla_stage3(const Ctx& c0, int layer, int unit, int cb, LAS unsigned char* lds) {
    const Ctx c = launder(c0);
    const int lane = c.lane, r = lane & 31, hi = lane >> 5;
    const int bh = unit >> 6, n = unit & 63, b = bh >> 2, h = bh & 3;
    const size_t row0 = (size_t)b * SEQ + n * 64 + 32 * cb;
    LAS unsigned char* R = lds + c.wid * G3_BYTES;
    const LAS unsigned char* Re = R + (4 * hi) * G3_PITCH + r * 2;
    const bf16* qgp = (const bf16*)(c.ws + O_QG) + (row0 + r) * 256 + h * 64 + 8 * hi;
    const float* sp = (const float*)(c.ws + O_UPD) + (size_t)unit * 8192;
    const float* gn = c.a->in[I_GNORM] + (size_t)layer * 128;
    bf16x8 qf[4];
#pragma unroll
    for (int s = 0; s < 4; ++s) qf[s] = *(const bf16x8*)(qgp + 16 * s);
    f32x16 o[4];
#pragma unroll
    for (int vb = 0; vb < 4; ++vb) {
        o[vb] = f32x16{};
#pragma unroll
        for (int s = 0; s < 4; ++s) { const float* s0 = sp + (size_t)(16 * s + 8 * hi) * 128 + 32 * vb + r;
            const bf16x8 bfv = pack8(s0[0], s0[128], s0[256], s0[384], s0[512], s0[640], s0[768], s0[896]);
            o[vb] = MFMA32(qf[s], bfv, o[vb]); }
        asm volatile("" ::: "memory");
    }
    g3_tile_in((const bf16*)(c.ws + O_OINTRA) + row0 * 512 + h * 128, R, lane);
#pragma unroll
    for (int vb = 0; vb < 4; ++vb) {
#pragma unroll
        for (int rg = 0; rg < 16; ++rg) o[vb][rg] += bf2f(*(const LAS bf16*)(Re + ((rg & 3) + 8 * (rg >> 2)) * G3_PITCH + 64 * vb));
        asm volatile("" ::: "memory");
    }
    float rs[16];
#pragma unroll
    for (int rg = 0; rg < 16; ++rg) { float ss = o[0][rg] * o[0][rg] + o[1][rg] * o[1][rg] + o[2][rg] * o[2][rg] + o[3][rg] * o[3][rg];
        ss += __shfl_xor(ss, 1); ss += __shfl_xor(ss, 2); ss += __shfl_xor(ss, 4); ss += __shfl_xor(ss, 8); ss += __shfl_xor(ss, 16);
        rs[rg] = 1.f / sqrtf(ss * (1.f / 128.f) + EPS); }
    LDS_WAIT();
    g3_tile_in((const bf16*)(c.ws + O_GR) + row0 * 512 + h * 128, R, lane);
#pragma unroll
    for (int vb = 0; vb < 4; ++vb) { const float g = gn[32 * vb + r];
#pragma unroll
        for (int rg = 0; rg < 16; ++rg) { LAS bf16* e = (LAS bf16*)(R + (4 * hi) * G3_PITCH + r * 2 + ((rg & 3) + 8 * (rg >> 2)) * G3_PITCH + 64 * vb);
            const float z = bf2f(*e);
            *e = (bf16)(cvtpk(o[vb][rg] * rs[rg] * g * siluf_(z), 0.f) & 0xffffu); }
        asm volatile("" ::: "memory"); }
    g3_tile_out((bf16*)(c.ws + O_OGLA) + row0 * 512 + h * 128, R, lane);
}
constexpr int A_KT = 0, A_VT = 16384, A_WSF = 32768, A_IMP = 36864, A_SEL = A_IMP + 65536, A_OC = A_SEL + 512, A_END = A_OC + 32768;
struct ASt { float m, l; f32x16 o0, o1; };
struct TileRegs { u32x4 k, v; };
DI TileRegs tile_fetch(const bf16* Kg, const bf16* Vg, int tok0, int tid) {
    TileRegs t; const size_t off = (size_t)(tok0 + (tid >> 3)) * 64 + (tid & 7) * 8;
    t.k = *(const u32x4*)(Kg + off); t.v = *(const u32x4*)(Vg + off); return t;
}
DI void tile_stage(const TileRegs& t, LAS unsigned char* lds, int buf, int tid) {
    const int kv = tid >> 3, ch = tid & 7;
    *(LAS u32x4*)(lds + A_KT + buf * 8192 + ch * 1024 + ((kv ^ (2 * ch)) * 16)) = t.k;
    *(LAS u32x4*)(lds + A_VT + buf * 8192 + (ch >> 2) * 4096 + kv * 64 + (ch & 3) * 16) = t.v;
}
template <bool CMP> DI void tile_compute(LAS unsigned char* lds, int buf, const bf16x8 (&q)[4], int lo, int hv, ASt& st, f32x16& imp0, f32x16& imp1, int jt, LAS float* wsf, int lane) {
    const int r = lane & 31, hi = lane >> 5;
    const LAS unsigned char* kb0 = lds + A_KT + buf * 8192 + hi * 1024;
    f32x16 p0 = {}, p1 = {};
#pragma unroll
    for (int s = 0; s < 4; ++s) { const LAS unsigned char* kb = kb0 + ((r ^ (4 * s + 2 * hi)) * 16);
        const bf16x8 a0 = *(const LAS bf16x8*)(kb + s * 2048), a1 = *(const LAS bf16x8*)(kb + s * 2048 + 512);
        p0 = MFMA32(a0, q[s], p0); p1 = MFMA32(a1, q[s], p1); }
    const bool dead = lo > hv;
    const bool part = !dead && (lo > 0 || hv < 63);
    const bool anyPart = __builtin_amdgcn_ballot_w64(part) != 0ull;
    if (anyPart) {
#pragma unroll
        for (int rg = 0; rg < 16; ++rg) { const int k0 = crow(rg, hi), k1 = k0 + 32;
            p0[rg] = (k0 >= lo && k0 <= hv) ? p0[rg] : NEGB; p1[rg] = (k1 >= lo && k1 <= hv) ? p1[rg] : NEGB; }
    }
    float mx = __builtin_fmaxf(p0[0], p1[0]);
#pragma unroll
    for (int rg = 1; rg < 16; ++rg) mx = __builtin_fmaxf(__builtin_fmaxf(mx, p0[rg]), p1[rg]);
    if (!anyPart && dead) mx = NEGB;
    mx = __builtin_fmaxf(mx, __shfl_xor(mx, 32));
    const float mnew = fmaxf(st.m, mx);
    const float alpha = __builtin_amdgcn_exp2f(st.m - mnew);
    st.m = mnew;
    float sum = 0.f;
    const float msub = (!anyPart && dead) ? 1e30f : mnew;
#pragma unroll
    for (int rg = 0; rg < 16; ++rg) { p0[rg] = __builtin_amdgcn_exp2f(p0[rg] - msub); p1[rg] = __builtin_amdgcn_exp2f(p1[rg] - msub); sum += p0[rg] + p1[rg]; }
    st.l = st.l * alpha + sum;
    if (__builtin_amdgcn_ballot_w64(alpha != 1.f) != 0ull) {
        if (hi == 0) wsf[r] = alpha;
        LDS_WAIT();
#pragma unroll
        for (int g4 = 0; g4 < 4; ++g4) { const f32x4 f = *(const LAS f32x4*)(wsf + 8 * g4 + 4 * hi);
#pragma unroll
            for (int k = 0; k < 4; ++k) { st.o0[4 * g4 + k] *= f[k]; st.o1[4 * g4 + k] *= f[k]; if (CMP) { imp0[4 * g4 + k] *= f[k]; imp1[4 * g4 + k] *= f[k]; } } }
        LDS_WAIT();
    }
    bf16x8 pa[4];
    pa[0] = pack8(p0[0], p0[1], p0[2], p0[3], p0[4], p0[5], p0[6], p0[7]); pa[1] = pack8(p0[8], p0[9], p0[10], p0[11], p0[12], p0[13], p0[14], p0[15]);
    pa[2] = pack8(p1[0], p1[1], p1[2], p1[3], p1[4], p1[5], p1[6], p1[7]); pa[3] = pack8(p1[8], p1[9], p1[10], p1[11], p1[12], p1[13], p1[14], p1[15]);
    const LAS unsigned char* vb = lds + A_VT + buf * 8192 + (4 * hi + ((lane & 15) >> 2)) * 64 + ((lane >> 4) & 1) * 32 + (lane & 3) * 8;
#pragma unroll
    for (int s = 0; s < 4; ++s) {
        const bf16x8 v0 = cat8(vtr(vb + s * 1024), vtr(vb + s * 1024 + 512));
        const bf16x8 v1 = cat8(vtr(vb + 4096 + s * 1024), vtr(vb + 4096 + s * 1024 + 512));
        st.o0 = MFMA32(pa[s], v0, st.o0); st.o1 = MFMA32(pa[s], v1, st.o1);
    }
    if (CMP) {
#pragma unroll
        for (int s = 0; s < 4; ++s) {
            bf16x8 w0, w1;
#pragma unroll
            for (int j = 0; j < 8; ++j) { const int jj = 64 * jt + 16 * s + 8 * (j >> 2) + 4 * hi + (j & 3);
                const int n0 = r, n1 = 32 + r;
                w0[j] = (jj >= 4 * n0 - 1 && jj <= 4 * n0 + 3) ? (short)0x3F80 : (short)0;
                w1[j] = (jj >= 4 * n1 - 1 && jj <= 4 * n1 + 3) ? (short)0x3F80 : (short)0; }
            imp0 = MFMA32(pa[s], w0, imp0); imp1 = MFMA32(pa[s], w1, imp1); asm volatile("" ::: "memory");
        }
    }
}
DI void branch_fold(ASt& st, float gate, bool may_be_empty, LAS float* wsf, int lane) {
    const int r = lane & 31, hi = lane >> 5;
    const float lt = st.l + __shfl_xor(st.l, 32);
    float inv = 1.f / lt; if (may_be_empty && !(st.m > -1e29f)) inv = 0.f;
    if (hi == 0) { wsf[r] = inv * gate; wsf[32 + r] = inv; }
    LDS_WAIT();
#pragma unroll
    for (int g4 = 0; g4 < 4; ++g4) { const f32x4 f = *(const LAS f32x4*)(wsf + 8 * g4 + 4 * hi);
#pragma unroll
        for (int k = 0; k < 4; ++k) { st.o0[4 * g4 + k] *= f[k]; st.o1[4 * g4 + k] *= f[k]; } }
}
DI void nsa_unit(const Ctx& c0, int b, int g, int i, LAS unsigned char* lds) {
    const Ctx c = launder(c0);
    const int tid = c.tid, lane = c.lane, wid = c.wid, r = lane & 31, hi = lane >> 5;
    const int hl = wid >> 1, qh = wid & 1, head = g * 4 + hl, ql = 32 * qh + r, t = i * 64 + ql;
    const size_t row = (size_t)b * SEQ + t;
    LAS float* wsf = (LAS float*)(lds + A_WSF) + wid * 64;
    LAS float* IMP = (LAS float*)(lds + A_IMP);
    LAS unsigned long long* SEL = (LAS unsigned long long*)(lds + A_SEL);
    const bf16* misc = (const bf16*)(c.ws + O_MISC);
    bf16x8 qn[4];
    { const bf16* qp = (const bf16*)(c.ws + O_QN) + row * 512 + head * 64 + 8 * hi;
#pragma unroll
      for (int s = 0; s < 4; ++s) qn[s] = *(const bf16x8*)(qp + 16 * s); }
    const float g_c = sigmoidf_(bf2f(misc[row * 64 + head * 3 + 0])), g_s = sigmoidf_(bf2f(misc[row * 64 + head * 3 + 1])), g_w = sigmoidf_(bf2f(misc[row * 64 + head * 3 + 2]));
#ifdef PROBE_NOC
    const float g_c2 = 0.f;
#else
    const float g_c2 = g_c;
#endif
#ifdef PROBE_NOS
    const float g_s2 = 0.f;
#else
    const float g_s2 = g_s;
#endif
#ifdef PROBE_NOW
    const float g_w2 = 0.f;
#else
    const float g_w2 = g_w;
#endif
    f32x16 dum0 = {}, dum1 = {};
    LAS float* OACC = (LAS float*)(lds + A_IMP) + wid * 2048 + lane;
    LAS unsigned* OC = (LAS unsigned*)(lds + A_OC) + wid * 1024 + lane;
    f32x16 ca0, ca1;
#ifndef SKN_CMP
    {
        const bf16* Kg = (const bf16*)(c.ws + O_KCMP) + ((size_t)(0 + g) * 2048 + b * 256) * 64;
        const bf16* Vg = (const bf16*)(c.ws + O_KCMP) + ((size_t)(2 + g) * 2048 + b * 256) * 64;
        const int nt = (4 * i + 3 + 63) >> 6;
        const int jmax = (t - 31) >> 4;
        ASt st; st.m = NEGB; st.l = 0.f; st.o0 = f32x16{}; st.o1 = f32x16{};
        f32x16 imp0 = {}, imp1 = {};
        TileRegs tr = tile_fetch(Kg, Vg, 0, tid);
        for (int k = 0; k < nt; ++k) {
            tile_stage(tr, lds, k & 1, tid);
            __syncthreads();
            if (k + 1 < nt) tr = tile_fetch(Kg, Vg, 64 * (k + 1), tid);
            int hv = jmax - 64 * k; hv = hv > 63 ? 63 : hv; const int lo = hv < 0 ? 64 : 0;
            tile_compute<true>(lds, k & 1, qn, lo, hv, st, imp0, imp1, k, wsf, lane);
        }
        branch_fold(st, g_c2, true, wsf, lane);
#pragma unroll
        for (int rg = 0; rg < 16; ++rg) OC[rg * 64] = cvtpk(st.o0[rg], st.o1[rg]);
#pragma unroll
        for (int g4 = 0; g4 < 4; ++g4) { const f32x4 f = *(const LAS f32x4*)(wsf + 32 + 8 * g4 + 4 * hi);
#pragma unroll
            for (int k = 0; k < 4; ++k) { const int qq = 32 * qh + 8 * g4 + 4 * hi + k;
                IMP[(hl * 64 + qq) * 64 + r] = imp0[4 * g4 + k] * f[k]; IMP[(hl * 64 + qq) * 64 + 32 + r] = imp1[4 * g4 + k] * f[k]; } }
        __syncthreads();
    }
#endif
    unsigned long long mysel, um;
    {
        const unsigned long long validm = (i >= 63) ? ~0ull : ((1ull << (i + 1)) - 1ull);
        if (i >= 16) {
            for (int qq = 8 * wid; qq < 8 * wid + 8; ++qq) {
                const int n = lane;
                const float v = ((IMP[(0 * 64 + qq) * 64 + n] + IMP[(1 * 64 + qq) * 64 + n]) + IMP[(2 * 64 + qq) * 64 + n]) + IMP[(3 * 64 + qq) * 64 + n];
                unsigned key = (__float_as_uint(fmaxf(v, 0.f)) & ~63u) | (unsigned)(63 - n);
                if (n == 0 || n == i || n == i - 1) key = 0xFFFFFFFFu;
                if (n > i) key = 0u;
                unsigned thr = 0u;
                for (int bit = 31; bit >= 0; --bit) { const unsigned cand = thr | (1u << bit);
                    const int cnt = __builtin_popcountll(__builtin_amdgcn_ballot_w64(key >= cand)); if (cnt >= 16) thr = cand; }
                const unsigned long long sm = __builtin_amdgcn_ballot_w64(key >= thr) & validm;
                if (lane == 0) SEL[qq] = sm;
            }
            __syncthreads();
            mysel = SEL[ql];
            unsigned long long u = SEL[lane];
            unsigned ulo = (unsigned)u, uhi = (unsigned)(u >> 32);
#pragma unroll
            for (int o = 1; o < 64; o <<= 1) { ulo |= __shfl_xor(ulo, o); uhi |= __shfl_xor(uhi, o); }
            um = ((unsigned long long)uhi << 32) | ulo;
        } else { mysel = validm; um = validm; }
    }
    bf16x8 qr[4];
    { const float* ct = (const float*)(c.ws + O_TAB) + (size_t)t * 32; const float* stb = ct + 4096 * 32;
#pragma unroll
      for (int s = 0; s < 2; ++s) {
          const f32x4 c0 = *(const f32x4*)(ct + 16 * s + 8 * hi), c1 = *(const f32x4*)(ct + 16 * s + 8 * hi + 4);
          const f32x4 s0 = *(const f32x4*)(stb + 16 * s + 8 * hi), s1 = *(const f32x4*)(stb + 16 * s + 8 * hi + 4);
          float lo_[8], hi_[8], ol[8], oh[8];
#pragma unroll
          for (int j = 0; j < 8; ++j) { lo_[j] = bf2f((bf16)qn[s][j]); hi_[j] = bf2f((bf16)qn[s + 2][j]); }
#pragma unroll
          for (int j = 0; j < 8; ++j) { const float cc = j < 4 ? c0[j & 3] : c1[j & 3], ss = j < 4 ? s0[j & 3] : s1[j & 3];
              ol[j] = lo_[j] * cc - hi_[j] * ss; oh[j] = hi_[j] * cc + lo_[j] * ss; }
          qr[s] = pack8(ol[0], ol[1], ol[2], ol[3], ol[4], ol[5], ol[6], ol[7]); qr[s + 2] = pack8(oh[0], oh[1], oh[2], oh[3], oh[4], oh[5], oh[6], oh[7]); } }
#ifndef SKN_SLC
    {
        const bf16* Kg = (const bf16*)(c.ws + O_KS) + ((size_t)g * T + (size_t)b * SEQ) * 64;
        const bf16* Vg = (const bf16*)(c.ws + O_VS) + ((size_t)g * T + (size_t)b * SEQ) * 64;
        ASt st; st.m = NEGB; st.l = 0.f; st.o0 = f32x16{}; st.o1 = f32x16{};
        unsigned long long rem = um;
        int n = __builtin_ctzll(rem); rem &= rem - 1ull;
        TileRegs tr = tile_fetch(Kg, Vg, 64 * n, tid);
        int k = 0;
        for (;;) {
            tile_stage(tr, lds, k & 1, tid);
            __syncthreads();
            const bool more = rem != 0ull; int nn = 0;
            if (more) { nn = __builtin_ctzll(rem); rem &= rem - 1ull; tr = tile_fetch(Kg, Vg, 64 * nn, tid); }
            const bool selb = (mysel >> n) & 1ull;
            const int lo = selb ? 0 : 64; const int hv = (n == i) ? ql : 63;
            tile_compute<false>(lds, k & 1, qr, lo, hv, st, dum0, dum1, 0, wsf, lane);
            ++k; if (!more) break; n = nn;
        }
        branch_fold(st, g_s2, false, wsf, lane);
#pragma unroll
        for (int rg = 0; rg < 16; ++rg) { OACC[rg * 64] = st.o0[rg]; OACC[(16 + rg) * 64] = st.o1[rg]; }
        __syncthreads();
    }
#endif
#ifndef SKN_WIN
    {
        const bf16* Kg = (const bf16*)(c.ws + O_KW) + ((size_t)g * T + (size_t)b * SEQ) * 64;
        const bf16* Vg = (const bf16*)(c.ws + O_VW) + ((size_t)g * T + (size_t)b * SEQ) * 64;
        ASt st; st.m = NEGB; st.l = 0.f; st.o0 = f32x16{}; st.o1 = f32x16{};
        const int nlast = i - 8 < 0 ? 0 : i - 8;
        TileRegs tr = tile_fetch(Kg, Vg, 64 * i, tid);
        int k = 0;
        for (int n = i; n >= nlast; --n, ++k) {
            tile_stage(tr, lds, k & 1, tid);
            __syncthreads();
            if (n - 1 >= nlast) tr = tile_fetch(Kg, Vg, 64 * (n - 1), tid);
            int lo = 0, hv = 63;
            if (n == i) hv = ql;
            if (n == i - 8) lo = ql + 1;
            tile_compute<false>(lds, k & 1, qr, lo, hv, st, dum0, dum1, 0, wsf, lane);
        }
        branch_fold(st, g_w2, false, wsf, lane);
#pragma unroll
        for (int rg = 0; rg < 16; ++rg) { const unsigned w = OC[rg * 64]; ca0[rg] = (OACC[rg * 64] + st.o0[rg]) + bflo(w); ca1[rg] = (OACC[(16 + rg) * 64] + st.o1[rg]) + bfhi(w); }
        __syncthreads();
    }
#endif
    { const size_t g0 = ((size_t)b * SEQ + i * 64 + 32 * qh) * 512 + head * 64;
      const bf16* nzg = (const bf16*)(c.ws + O_NZ) + g0; bf16* ong = (bf16*)(c.ws + O_ONSA) + g0;
      LAS unsigned char* S = lds + A_OC + wid * 4096;
#pragma unroll
      for (int it = 0; it < 4; ++it) { const int rw = 8 * it + (lane >> 3), ch = lane & 7;
          *(LAS u32x4*)(S + rw * 128 + ch * 16) = *(const u32x4*)(nzg + (size_t)rw * 512 + ch * 8); }
      LDS_WAIT();
#pragma unroll
      for (int rg = 0; rg < 16; ++rg) { LAS bf16* e = (LAS bf16*)(S + ((rg & 3) + 8 * (rg >> 2) + 4 * hi) * 128 + r * 2);
          const float z0 = bf2f(e[0]), z1 = bf2f(e[32]);
          e[0] = (bf16)(cvtpk(ca0[rg] * siluf_(z0), 0.f) & 0xffffu);
          e[32] = (bf16)(cvtpk(ca1[rg] * siluf_(z1), 0.f) & 0xffffu); }
      LDS_WAIT();
#pragma unroll
      for (int it = 0; it < 4; ++it) { const int rw = 8 * it + (lane >> 3), ch = lane & 7;
          *(u32x4*)(ong + (size_t)rw * 512 + ch * 8) = *(const LAS u32x4*)(S + rw * 128 + ch * 16); }
      LDS_WAIT(); }
}
DI void cmp_stage2(const Ctx& c0, int layer) {
    const Ctx c = launder(c0);
    const float* cp = (const float*)(c.ws + O_CPART); const float* cb = (const float*)(c.ws + O_CBIAS) + layer * 256;
    bf16* out = (bf16*)(c.ws + O_KCMP);
    for (int task = blockIdx.x * 512 + c.tid; task < 4 * 2048 * 8; task += c.G * 512) {
        const int oct = task & 7, row = (task >> 3) & 2047, which = task >> 14, kv = which >> 1;
        const float* w2 = c.a->in[kv ? I_CW2V : I_CW2K] + (size_t)layer * 128 * 64 + 8 * oct;
        const float* p0 = cp + ((size_t)which * 2048 + row) * 128;
        float acc[8] = {0.f, 0.f, 0.f, 0.f, 0.f, 0.f, 0.f, 0.f};
        for (int h4 = 0; h4 < 128; h4 += 4) {
            f32x4 s = *(const f32x4*)(p0 + h4);
#pragma unroll
            for (int ks = 1; ks < 4; ++ks) s += *(const f32x4*)(p0 + (size_t)ks * 4 * 2048 * 128 + h4);
            s += *(const f32x4*)(cb + kv * 128 + h4);
#pragma unroll
            for (int j = 0; j < 4; ++j) { const float hv = siluf_(s[j]); const f32x4 w0 = *(const f32x4*)(w2 + (size_t)(h4 + j) * 64), w1 = *(const f32x4*)(w2 + (size_t)(h4 + j) * 64 + 4);
                acc[0] += hv * w0[0]; acc[1] += hv * w0[1]; acc[2] += hv * w0[2]; acc[3] += hv * w0[3]; acc[4] += hv * w1[0]; acc[5] += hv * w1[1]; acc[6] += hv * w1[2]; acc[7] += hv * w1[3]; }
        }
        u32x4 w; w.x = cvtpk(acc[0], acc[1]); w.y = cvtpk(acc[2], acc[3]); w.z = cvtpk(acc[4], acc[5]); w.w = cvtpk(acc[6], acc[7]);
        *(u32x4*)(out + ((size_t)which * 2048 + row) * 64 + 8 * oct) = w;
    }
}
DI void post_phase(const Ctx& c0, int layer) {
    const Ctx c = launder(c0);
    const bf16* ob = (const bf16*)(c.ws + O_OUTB); const float* xin = layer == 0 ? c.a->in[I_X] : c.out;
    const float* gp = c.a->in[I_GPOST] + (size_t)layer * DM; const float* gn = c.a->in[I_GPRE] + (size_t)(layer + 1 < 2 ? layer + 1 : 1) * DM;
    const int gw = blockIdx.x * 8 + c.wid, NGW = c.G * 8, lane = c.lane;
    for (int m = gw; m < T; m += NGW) {
        float o[16]; float ss = 0.f;
#pragma unroll
        for (int j = 0; j < 2; ++j) { const u32x4 w = *(const u32x4*)(ob + (size_t)m * DM + 512 * j + 8 * lane);
            o[8 * j + 0] = bflo(w.x); o[8 * j + 1] = bfhi(w.x); o[8 * j + 2] = bflo(w.y); o[8 * j + 3] = bfhi(w.y); o[8 * j + 4] = bflo(w.z); o[8 * j + 5] = bfhi(w.z); o[8 * j + 6] = bflo(w.w); o[8 * j + 7] = bfhi(w.w); }
#pragma unroll
        for (int e = 0; e < 16; ++e) ss += o[e] * o[e];
        const float rr = 1.f / sqrtf(wave_sum(ss) * (1.f / 1024.f) + EPS);
        float xn[16]; float s2 = 0.f;
#pragma unroll
        for (int j = 0; j < 2; ++j)
#pragma unroll
            for (int q = 0; q < 2; ++q) { const size_t off = (size_t)m * DM + 512 * j + 8 * lane + 4 * q; const f32x4 xv = *(const f32x4*)(xin + off); const f32x4 g = *(const f32x4*)(gp + 512 * j + 8 * lane + 4 * q);
                f32x4 y;
#pragma unroll
                for (int k = 0; k < 4; ++k) { y[k] = xv[k] + o[8 * j + 4 * q + k] * rr * g[k]; xn[8 * j + 4 * q + k] = y[k]; s2 += y[k] * y[k]; }
                *(f32x4*)(c.out + off) = y; }
        if (layer == 0) {
            const float r2 = 1.f / sqrtf(wave_sum(s2) * (1.f / 1024.f) + EPS);
            bf16* hb = (bf16*)(c.ws + O_HB) + (size_t)m * DM;
#pragma unroll
            for (int j = 0; j < 2; ++j) { const f32x4 g0 = *(const f32x4*)(gn + 512 * j + 8 * lane), g1 = *(const f32x4*)(gn + 512 * j + 8 * lane + 4);
                u32x4 w; w.x = cvtpk(xn[8 * j] * r2 * g0[0], xn[8 * j + 1] * r2 * g0[1]); w.y = cvtpk(xn[8 * j + 2] * r2 * g0[2], xn[8 * j + 3] * r2 * g0[3]);
                w.z = cvtpk(xn[8 * j + 4] * r2 * g1[0], xn[8 * j + 5] * r2 * g1[1]); w.w = cvtpk(xn[8 * j + 6] * r2 * g1[2], xn[8 * j + 7] * r2 * g1[3]);
                *(u32x4*)(hb + 512 * j + 8 * lane) = w; }
        }
    }
}

constexpr size_t O_BAR = O_CBIAS + 65536;
DI Ctx make_ctx(const Args& a) {
    Ctx cb; cb.a = &a; cb.out = a.out; cb.ws = a.ws; cb.tid = threadIdx.x; cb.lane = cb.tid & 63; cb.wid = __builtin_amdgcn_readfirstlane(cb.tid >> 6); cb.G = gridDim.x;
    { const int bx = blockIdx.x; cb.vcu = (cb.G % 8 == 0) ? (bx % 8) * (cb.G / 8) + bx / 8 : bx; }
    return cb;
}
template <int PH> DI void run_phase(const Ctx& cb, LAS unsigned char* lds, int layer) {
    if constexpr (PH == 0) { phase0(cb, lds); }
    if constexpr (PH == 1) { const Ctx c = launder(cb); pg8::Gemm g{(const pg8::bf16_t*)(c.ws + O_HB), (const pg8::bf16_t*)(c.ws + O_WIN + (size_t)layer * 11 * MiB), T, NPHYS, 1024, 1024, 1024};
        pg8::StaticOrder S; S.init(T, NPHYS, c.G, (int)blockIdx.x); EpiProj E{c.ws};
        pg8::gemm_phase<EpiProj, pg8::StaticOrder, true, true>(lds, g, S, E); }
    if constexpr (PH == 2) {
        { const Ctx c = launder(cb);
          for (int cu = blockIdx.x; cu < 128; cu += c.G) { const int which = cu >> 5, ks = (cu >> 3) & 3, pm = cu & 7, kv = which >> 1;
            pg8::Gemm g{(const pg8::bf16_t*)(c.ws + O_KCRAW) + (size_t)which * KCR_ROWS * 64 + ks * 512,
                        (const pg8::bf16_t*)(c.ws + O_WC1 + (size_t)(layer * 2 + kv) * MiB) + ks * 512, 2048, 256, 512, 1024, 2048};
            OneUnit S{pm, true}; EpiCPart E{(float*)(c.ws + O_CPART) + ((size_t)(ks * 4 + which) * 2048) * 128};
            pg8::gemm_phase<EpiCPart, OneUnit, false, true>(lds, g, S, E); } }
        __syncthreads();
        {
          const int bx = blockIdx.x; const bool bal = cb.G == 256;
          const int nun = bal ? (bx < 128 ? 7 : 9) : (2048 - bx + cb.G - 1) / cb.G;
          for (int k = 0; k < nun; ++k) { const int u = bal ? (k < 7 ? bx + 256 * k : 1792 + 2 * (bx - 128) + (k - 7)) : bx + cb.G * k; gla_stage1(cb, layer, u, lds); } }
    }
    if constexpr (PH == 3) { cmp_stage2(cb, layer); { const Ctx c = launder(cb); gla_stage2(c); } }
    if constexpr (PH == 4) {
        for (int sl = cb.vcu; sl < 256; sl += cb.G) { const int bg = sl >> 4, s = sl & 15;
#pragma unroll 1
            for (int it = 0; it < 4; ++it) { const int i = (it == 0) ? s : (it == 1) ? 31 - s : (it == 2) ? 32 + s : 63 - s; nsa_unit(cb, bg >> 1, bg & 1, i, lds); } }
        __syncthreads();
        for (int pu = blockIdx.x * 4 + (cb.wid >> 1); pu < 2048; pu += cb.G * 4) gla_stage3(cb, layer, pu, cb.wid & 1, lds);
#ifdef PROBE_G3X2
        __syncthreads();
        for (int pu = blockIdx.x * 4 + (cb.wid >> 1); pu < 2048; pu += cb.G * 4) gla_stage3(cb, layer, pu, cb.wid & 1, lds);
#endif
    }
    if constexpr (PH == 5) {
        { const Ctx c = launder(cb); pg8::Gemm g{(const pg8::bf16_t*)(c.ws + O_ONSA), (const pg8::bf16_t*)(c.ws + O_WUPN + (size_t)layer * MiB), T, 1024, 512, 512, 512};
          pg8::StaticOrder S; S.init(T, 1024, c.G, (int)blockIdx.x); EpiUp<false> E{(const bf16*)(c.ws + O_MG), (bf16*)(c.ws + O_Y)};
          pg8::gemm_phase<EpiUp<false>, pg8::StaticOrder, true, true>(lds, g, S, E); }
        __syncthreads();
        { const Ctx c = launder(cb); pg8::Gemm g{(const pg8::bf16_t*)(c.ws + O_OGLA), (const pg8::bf16_t*)(c.ws + O_WUPG + (size_t)layer * MiB), T, 1024, 512, 512, 512};
          pg8::StaticOrder S; S.init(T, 1024, c.G, (int)blockIdx.x); EpiUp<true> E{(const bf16*)(c.ws + O_MG) + 1024, (bf16*)(c.ws + O_Y)};
          pg8::gemm_phase<EpiUp<true>, pg8::StaticOrder, true, true>(lds, g, S, E); }
    }
    if constexpr (PH == 6) { const Ctx c = launder(cb); pg8::Gemm g{(const pg8::bf16_t*)(c.ws + O_Y), (const pg8::bf16_t*)(c.ws + O_WOUT + (size_t)layer * 2 * MiB), T, 1024, 1024, 1024, 1024};
        pg8::StaticOrder S; S.init(T, 1024, c.G, (int)blockIdx.x); EpiPlain E{(bf16*)(c.ws + O_OUTB), 1024};
        pg8::gemm_phase<EpiPlain, pg8::StaticOrder, true, true>(lds, g, S, E); }
    if constexpr (PH == 7) { post_phase(cb, layer); }
}
#ifndef ONE_LAUNCH
#define ONE_LAUNCH 1
#endif
#ifndef PLAN
#define PLAN 0
#endif
#if ONE_LAUNCH
template <int L> DI void run_layer(const Ctx& cb, LAS unsigned char* lds, const XcdBarrier& xbar, bool last) {
    run_phase<1>(cb, lds, L); xcd_barrier(xbar);
    run_phase<2>(cb, lds, L); xcd_barrier(xbar);
    run_phase<3>(cb, lds, L); xcd_barrier(xbar);
    run_phase<4>(cb, lds, L); xcd_barrier(xbar);
    run_phase<5>(cb, lds, L); xcd_barrier(xbar);
    run_phase<6>(cb, lds, L); xcd_barrier(xbar);
    run_phase<7>(cb, lds, L); if (!last) xcd_barrier(xbar);
}
__global__ void __launch_bounds__(512, 2) nsa_gla_fwd(Args a) {
    extern __shared__ __attribute__((aligned(16))) unsigned char lds_raw[];
    LAS unsigned char* lds = (LAS unsigned char*)lds_raw;
    cg::grid_group grid = cg::this_grid();
    const Ctx cb = make_ctx(a);
    volatile LAS unsigned* bst = (volatile LAS unsigned*)(lds + LDS_BYTES - 64);
    if (threadIdx.x == 0) { bst[0] = 0u; bst[1] = 0u; }
    __syncthreads();
    const XcdBarrier xbar = xcd_barrier_post((unsigned*)(a.ws + O_BAR), bst);
    run_phase<0>(cb, lds, 0);
    xcd_barrier(xbar);
    run_layer<0>(cb, lds, xbar, false);
    run_layer<1>(cb, lds, xbar, true);
    if (gridDim.x > 100000u) grid.sync();
}
#else
template <int PH> __global__ void __launch_bounds__(512, 2) k_phase(Args a, int layer) {
    extern __shared__ __attribute__((aligned(16))) unsigned char lds_raw[];
    LAS unsigned char* lds = (LAS unsigned char*)lds_raw;
    const Ctx cb = make_ctx(a);
    run_phase<PH>(cb, lds, layer);
}
template <int LO, int HI> __global__ void __launch_bounds__(512, 2) k_range(Args a, int layer, int region) {
    extern __shared__ __attribute__((aligned(16))) unsigned char lds_raw[];
    LAS unsigned char* lds = (LAS unsigned char*)lds_raw;
    cg::grid_group grid = cg::this_grid();
    const Ctx cb = make_ctx(a);
    volatile LAS unsigned* bst = (volatile LAS unsigned*)(lds + LDS_BYTES - 64);
    if (threadIdx.x == 0) { bst[0] = 0u; bst[1] = 0u; }
    __syncthreads();
    const XcdBarrier xbar = xcd_barrier_post((unsigned*)(a.ws + O_BAR) + 4096 * region, bst);
    if constexpr (LO <= 1 && 1 <= HI) { run_phase<1>(cb, lds, layer); if constexpr (1 < HI) xcd_barrier(xbar); }
    if constexpr (LO <= 2 && 2 <= HI) { run_phase<2>(cb, lds, layer); if constexpr (2 < HI) xcd_barrier(xbar); }
    if constexpr (LO <= 3 && 3 <= HI) { run_phase<3>(cb, lds, layer); if constexpr (3 < HI) xcd_barrier(xbar); }
    if constexpr (LO <= 4 && 4 <= HI) { run_phase<4>(cb, lds, layer); if constexpr (4 < HI) xcd_barrier(xbar); }
    if constexpr (LO <= 5 && 5 <= HI) { run_phase<5>(cb, lds, layer); if constexpr (5 < HI) xcd_barrier(xbar); }
    if constexpr (LO <= 6 && 6 <= HI) { run_phase<6>(cb, lds, layer); if constexpr (6 < HI) xcd_barrier(xbar); }
    if constexpr (LO <= 7 && 7 <= HI) { run_phase<7>(cb, lds, layer); }
    if (layer > 1000) grid.sync();
}
template <int LO, int HI> static void launch_range(const Args& a, int layer, int region, hipStream_t stream) {
    static bool attr = false;
    if (!attr) { (void)hipFuncSetAttribute((const void*)k_range<LO, HI>, hipFuncAttributeMaxDynamicSharedMemorySize, LDS_BYTES); attr = true; }
    Args aa = a; int ll = layer, rr = region; void* args[] = {&aa, &ll, &rr};
    hipError_t e = hipLaunchCooperativeKernel((const void*)k_range<LO, HI>, dim3(256), dim3(512), args, LDS_BYTES, stream);
    if (e != hipSuccess) fprintf(stderr, "k_range<%d,%d> cooperative launch failed: %s\n", LO, HI, hipGetErrorString(e));
}
template <int PH> static void launch_phase(const Args& a, int layer, hipStream_t stream) {
    static bool attr = false;
    if (!attr) { (void)hipFuncSetAttribute((const void*)k_phase<PH>, hipFuncAttributeMaxDynamicSharedMemorySize, LDS_BYTES); attr = true; }
    hipLaunchKernelGGL(k_phase<PH>, dim3(256), dim3(512), LDS_BYTES, stream, a, layer);
}
#endif

extern "C" void kernel_launch(void* const* d_in, const int* in_sizes, int n_in, void* d_out, int out_size, void* d_ws, size_t ws_size, hipStream_t stream) {
    if (n_in != 16 || ws_size < WS_END) { fprintf(stderr, "kernel_launch: need 16 inputs and %zu bytes of workspace (got %d, %zu)\n", (size_t)WS_END, n_in, ws_size); return; }
    Args a{};
    for (int i = 0; i < 16; ++i) a.in[i] = (const float*)d_in[i];
    a.out = (float*)d_out; a.ws = (unsigned char*)d_ws;
#if ONE_LAUNCH
    static int grid = 0;
    if (grid == 0) {
        int dev = 0, cus = 0, per_cu = 0;
        (void)hipGetDevice(&dev); (void)hipDeviceGetAttribute(&cus, hipDeviceAttributeMultiprocessorCount, dev);
        if (hipFuncSetAttribute((const void*)nsa_gla_fwd, hipFuncAttributeMaxDynamicSharedMemorySize, LDS_BYTES) != hipSuccess) { fprintf(stderr, "kernel_launch: hipFuncSetAttribute failed\n"); grid = -1; return; }
        if (hipOccupancyMaxActiveBlocksPerMultiprocessor(&per_cu, (const void*)nsa_gla_fwd, 512, LDS_BYTES) != hipSuccess || per_cu < 1) { fprintf(stderr, "kernel_launch: occupancy query gave %d\n", per_cu); per_cu = 1; }
        (void)hipGetLastError();
        grid = cus * per_cu; if (grid > 256) grid = 256;
    }
    if (grid < 0) return;
    if (hipMemsetAsync((char*)d_ws + O_BAR, 0, 16384, stream) != hipSuccess) { fprintf(stderr, "kernel_launch: memset failed\n"); return; }
    void* args[] = {&a};
    hipError_t e = hipLaunchCooperativeKernel((const void*)nsa_gla_fwd, dim3(grid), dim3(512), args, LDS_BYTES, stream);
    if (e != hipSuccess) fprintf(stderr, "cooperative launch failed: %s (grid %d)\n", hipGetErrorString(e), grid);
#else
    if (hipMemsetAsync((char*)d_ws + O_BAR, 0, 16 * 16384, stream) != hipSuccess) { fprintf(stderr, "kernel_launch: memset failed\n"); return; }
    launch_phase<0>(a, 0, stream);
    for (int layer = 0; layer < 2; ++layer) {
#if PLAN == 1
        launch_phase<1>(a, layer, stream); launch_range<2, 3>(a, layer, layer * 4 + 0, stream); launch_phase<4>(a, layer, stream); launch_range<5, 7>(a, layer, layer * 4 + 1, stream);
#elif PLAN == 2
        launch_range<1, 3>(a, layer, layer * 4 + 0, stream); launch_phase<4>(a, layer, stream); launch_range<5, 7>(a, layer, layer * 4 + 1, stream);
#elif PLAN == 3
        launch_range<1, 3>(a, layer, layer * 4 + 0, stream); launch_range<4, 7>(a, layer, layer * 4 + 1, stream);
#elif PLAN == 4
        launch_range<1, 7>(a, layer, layer * 4 + 0, stream);
#else
        launch_phase<1>(a, layer, stream); launch_phase<2>(a, layer, stream); launch_phase<3>(a, layer, stream); launch_phase<4>(a, layer, stream);
        launch_phase<5>(a, layer, stream); launch_phase<6>(a, layer, stream); launch_phase<7>(a, layer, stream);
#endif
    }
#endif
}
```

```cpp
#include <hip/hip_runtime.h>
#include <hip/hip_cooperative_groups.h>
#include <cstdio>
#include <cstdint>
#include <cmath>
namespace cg = cooperative_groups;
namespace pg8 {
#define PG8_LAS __attribute__((address_space(3)))
typedef unsigned short bf16_t;
typedef short bf16x8 __attribute__((ext_vector_type(8)));
typedef float f32x4 __attribute__((ext_vector_type(4)));
typedef unsigned u32x4 __attribute__((ext_vector_type(4)));
constexpr int BM = 256, BK = 64, HALF = 128, HTB = HALF * BK * 2  , STAGE_BYTES = 8 * HTB, NXCD = 8, WGM = 8;

__host__ __device__ __forceinline__ int lds_byte(int r, int c) { const int st = (r >> 4) * 2 + (c >> 5), rr = r & 15, cc = c & 31, ob = rr * 64 + cc * 2; return st * 1024 + (ob ^ (((ob >> 9) & 1) << 5)); }
__host__ __device__ __forceinline__ void stage_rc(int b, int& R, int& C) { const int st = b / 1024, sb = b % 1024, swz = sb ^ (((sb >> 9) & 1) << 5); R = (st >> 1) * 16 + swz / 64; C = (st & 1) * 32 + (swz % 64) / 2; }
__host__ __device__ __forceinline__ int perm32(int rho) { const int n = rho >> 4, i = rho & 15; return 8 * (i >> 2) + 4 * n + (i & 3); }

struct Unit { int pm, pn; };
struct Gemm { const bf16_t* A; const bf16_t* Bt; int M, N, K, lda, ldb; };

struct StaticOrder {
    int nM, nN, nwg, G, c;
    __host__ __device__ void init(int M, int N, int G_, int c_) { nM = M / BM; nN = N / BM; nwg = nM * nN; G = G_; c = c_; }
    __host__ __device__ bool next(int i, Unit& u) const {
        const long L = (long)i * G + c; if (L >= nwg) return false;
        int wgid = (int)L; { const int q = nwg / NXCD, r = nwg % NXCD, xcd = wgid % NXCD, off = wgid / NXCD; wgid = (xcd < r ? xcd * (q + 1) : r * (q + 1) + (xcd - r) * q) + off; }
        const int nig = WGM * nN, gid = wgid / nig, fm = gid * WGM, gsz = (nM - fm) < WGM ? (nM - fm) : WGM;
        u.pm = fm + ((wgid % nig) % gsz); u.pn = (wgid % nig) / gsz; return true;
    }
    __device__ __forceinline__ void a_ready(const Unit&) const {}
    __device__ __forceinline__ void done(const Unit&) const {}
};

__device__ __forceinline__ unsigned cvt_pk_bf16(float lo, float hi) { unsigned r; asm volatile("v_cvt_pk_bf16_f32 %0, %1, %2" : "=v"(r) : "v"(lo), "v"(hi)); return r; }
typedef float f32x2 __attribute__((ext_vector_type(2)));
template <class Epi, class Sched, bool ALIGN_EPI = false, bool SP2 = false>
__device__ __forceinline__ void gemm_phase(PG8_LAS unsigned char* lds, const Gemm g, const Sched& S, const Epi& E) {
    int tid_ = threadIdx.x; asm volatile("" : "+v"(tid_)); const int tid = tid_, wid = __builtin_amdgcn_readfirstlane(tid >> 6), lane = tid & 63, wr = wid >> 2, wc = wid & 3, fr = lane & 15, fq = lane >> 4;
    const int K = g.K, nt = K / BK;
    unsigned voffA[2], voffB[2];
#pragma unroll
    for (int i = 0; i < 2; ++i) { int R, C; stage_rc(tid * 16 + i * 8192, R, C); const int Rb = Epi::PERM ? ((R & ~31) + perm32(R & 31)) : R;
        voffA[i] = (unsigned)(R * g.lda + C) * 2u; voffB[i] = (unsigned)(Rb * g.ldb + C) * 2u; }
    const size_t kstep = (size_t)(BK * 2);
    const size_t hstepA = (size_t)HALF * g.lda * 2, hstepB = (size_t)HALF * g.ldb * 2;
    const size_t tstepA = 2 * hstepA, tstepB = 2 * hstepB;
    const unsigned ldsw = (unsigned)wid * 1024u;
    const int aoff = lds_byte(wr * 64 + fr, fq * 8), boff = lds_byte(wc * 32 + fr, fq * 8);
#define PG8_SA(b, h) (((b) * 2 + (h)) * HTB)
#define PG8_SB(b, h) ((4 + (b) * 2 + (h)) * HTB)
#define PG8_STAGE(bufoff, gbase, voff) do { _Pragma("unroll") for (int _i = 0; _i < 2; ++_i) \
        __builtin_amdgcn_global_load_lds((const unsigned*)((const char*)(gbase) + (voff)[_i]), (PG8_LAS unsigned*)(lds + (bufoff) + ldsw + _i * 8192), 16, 0, 0); } while (0)
#define PG8_LDA(dst, b, h) do { _Pragma("unroll") for (int m = 0; m < 4; ++m) _Pragma("unroll") for (int k = 0; k < 2; ++k) dst[m][k] = *(const PG8_LAS bf16x8*)(lds + PG8_SA(b, h) + aoff + m * 2048 + k * 1024); } while (0)
#define PG8_LDB(dst, b, h) do { _Pragma("unroll") for (int n = 0; n < 2; ++n) _Pragma("unroll") for (int k = 0; k < 2; ++k) dst[n][k] = *(const PG8_LAS bf16x8*)(lds + PG8_SB(b, h) + boff + n * 2048 + k * 1024); } while (0)
#define PG8_MMA(ai, bj, At, Bt) do { __builtin_amdgcn_s_setprio(1); _Pragma("unroll") for (int m = 0; m < 4; ++m) _Pragma("unroll") for (int n = 0; n < 2; ++n) _Pragma("unroll") for (int k = 0; k < 2; ++k) \
        acc[ai][bj][m][n] = __builtin_amdgcn_mfma_f32_16x16x32_bf16(Bt[n][k], At[m][k], acc[ai][bj][m][n], 0, 0, 0); __builtin_amdgcn_s_setprio(0); } while (0)
#define PG8_WAIT_V(n) asm volatile("s_waitcnt vmcnt(" #n ")" ::: "memory")
#define PG8_WAIT_L(n) asm volatile("s_waitcnt lgkmcnt(" #n ")" ::: "memory")
#define PG8_BAR __builtin_amdgcn_s_barrier()
#define PG8_SCHED __builtin_amdgcn_sched_barrier(0)
    Unit cur, nxt; int ui = 0;
    if (!S.next(0, cur)) return;
    f32x4 acc[2][2][4][2];
#pragma unroll
    for (int a = 0; a < 2; ++a)
#pragma unroll
        for (int b = 0; b < 2; ++b)
#pragma unroll
            for (int m = 0; m < 4; ++m)
#pragma unroll
                for (int n = 0; n < 2; ++n) acc[a][b][m][n] = (f32x4){0.f, 0.f, 0.f, 0.f};
    bf16x8 At[4][2], B0[2][2], B1[2][2];
    const char* cA = (const char*)g.A + (size_t)cur.pm * tstepA; const char* cB = (const char*)g.Bt + (size_t)cur.pn * tstepB;
    S.a_ready(cur);
    if constexpr (SP2) {
        PG8_STAGE(PG8_SB(0, 0), cB, voffB); PG8_STAGE(PG8_SB(0, 1), cB + hstepB, voffB); PG8_STAGE(PG8_SA(0, 0), cA, voffA); PG8_STAGE(PG8_SA(0, 1), cA + hstepA, voffA);
        if (wr == 1) PG8_BAR;
        PG8_WAIT_V(2); PG8_BAR;
        PG8_STAGE(PG8_SB(1, 0), cB + kstep, voffB); PG8_STAGE(PG8_SA(1, 0), cA + kstep, voffA); PG8_STAGE(PG8_SB(1, 1), cB + hstepB + kstep, voffB);
        PG8_WAIT_V(6); PG8_BAR;
    } else {
        PG8_STAGE(PG8_SB(0, 0), cB, voffB); PG8_STAGE(PG8_SA(0, 0), cA, voffA); PG8_STAGE(PG8_SB(0, 1), cB + hstepB, voffB); PG8_STAGE(PG8_SA(0, 1), cA + hstepA, voffA);
        if (wr == 1) PG8_BAR;
        PG8_WAIT_V(4); PG8_BAR;
        PG8_STAGE(PG8_SB(1, 0), cB + kstep, voffB); PG8_STAGE(PG8_SA(1, 0), cA + kstep, voffA); PG8_STAGE(PG8_SB(1, 1), cB + hstepB + kstep, voffB);
        PG8_WAIT_V(6); PG8_BAR;
    }
    for (;;) {
        const bool has_next = S.next(ui + 1, nxt);
        const char* nA = has_next ? (const char*)g.A + (size_t)nxt.pm * tstepA : cA; const char* nB = has_next ? (const char*)g.Bt + (size_t)nxt.pn * tstepB : cB;
        for (int t = 0; t < nt; t += 2) {
            const bool last = (t == nt - 2);
            const char* a1 = cA + (size_t)(t + 1) * kstep;
            const char* a2 = last ? nA : cA + (size_t)(t + 2) * kstep; const char* b2 = last ? nB : cB + (size_t)(t + 2) * kstep;
            const char* a3 = a2 + kstep; const char* b3 = b2 + kstep;
            if (last && has_next) S.a_ready(nxt);
            if constexpr (SP2) {
            PG8_LDB(B0, 0, 0); PG8_LDB(B1, 0, 1); PG8_SCHED; PG8_LDA(At, 0, 0); PG8_STAGE(PG8_SA(1, 1), a1 + hstepA, voffA);
            PG8_WAIT_V(8); PG8_WAIT_L(0); PG8_BAR; PG8_MMA(0, 0, At, B0); PG8_MMA(0, 1, At, B1); PG8_BAR; PG8_SCHED;
            PG8_LDA(At, 0, 1); PG8_STAGE(PG8_SB(0, 0), b2, voffB); PG8_STAGE(PG8_SB(0, 1), b2 + hstepB, voffB); PG8_STAGE(PG8_SA(0, 0), a2, voffA);
            PG8_WAIT_V(8); PG8_WAIT_L(0); PG8_BAR; PG8_MMA(1, 0, At, B0); PG8_MMA(1, 1, At, B1); PG8_BAR; PG8_SCHED;
            PG8_LDB(B0, 1, 0); PG8_LDB(B1, 1, 1); PG8_SCHED; PG8_LDA(At, 1, 0); PG8_STAGE(PG8_SA(0, 1), a2 + hstepA, voffA);
            PG8_WAIT_V(8); PG8_WAIT_L(0); PG8_BAR; PG8_MMA(0, 0, At, B0); PG8_MMA(0, 1, At, B1); PG8_BAR; PG8_SCHED;
            PG8_LDA(At, 1, 1); PG8_STAGE(PG8_SB(1, 0), b3, voffB); PG8_STAGE(PG8_SB(1, 1), b3 + hstepB, voffB); PG8_STAGE(PG8_SA(1, 0), a3, voffA);
            PG8_WAIT_V(8); PG8_WAIT_L(0); PG8_BAR; PG8_MMA(1, 0, At, B0); PG8_MMA(1, 1, At, B1); PG8_BAR; PG8_SCHED;
            } else {
            PG8_LDB(B0, 0, 0); PG8_SCHED; PG8_LDA(At, 0, 0); PG8_STAGE(PG8_SA(1, 1), a1 + hstepA, voffA);
            PG8_WAIT_L(8); PG8_BAR; PG8_WAIT_L(0); PG8_MMA(0, 0, At, B0); PG8_BAR; PG8_SCHED;
            PG8_LDB(B1, 0, 1); PG8_STAGE(PG8_SB(0, 0), b2, voffB);
            PG8_BAR; PG8_WAIT_L(0); PG8_MMA(0, 1, At, B1); PG8_BAR;
            PG8_LDA(At, 0, 1); PG8_STAGE(PG8_SA(0, 0), a2, voffA);
            PG8_BAR; PG8_WAIT_L(0); PG8_MMA(1, 0, At, B0); PG8_BAR; PG8_SCHED;
            PG8_STAGE(PG8_SB(0, 1), b2 + hstepB, voffB);
            PG8_WAIT_V(6); PG8_BAR; PG8_MMA(1, 1, At, B1); PG8_BAR;
            PG8_LDB(B0, 1, 0); PG8_SCHED; PG8_LDA(At, 1, 0); PG8_STAGE(PG8_SA(0, 1), a2 + hstepA, voffA);
            PG8_WAIT_L(8); PG8_BAR; PG8_WAIT_L(0); PG8_MMA(0, 0, At, B0); PG8_BAR; PG8_SCHED;
            PG8_LDB(B1, 1, 1); PG8_STAGE(PG8_SB(1, 0), b3, voffB);
            PG8_BAR; PG8_WAIT_L(0); PG8_MMA(0, 1, At, B1); PG8_BAR;
            PG8_LDA(At, 1, 1); PG8_STAGE(PG8_SA(1, 0), a3, voffA);
            PG8_BAR; PG8_WAIT_L(0); PG8_MMA(1, 0, At, B0); PG8_BAR; PG8_SCHED;
            PG8_STAGE(PG8_SB(1, 1), b3 + hstepB, voffB);
            PG8_WAIT_V(6); PG8_BAR; PG8_MMA(1, 1, At, B1); PG8_BAR;
            }
        }
        if constexpr (ALIGN_EPI) { if (wr == 0) PG8_BAR; }
        if constexpr (!Epi::AFTER_DRAIN) { E(acc, cur, wr, wc, fr, fq); S.done(cur); }
        if (!has_next) break;
#pragma unroll
        for (int a = 0; a < 2; ++a)
#pragma unroll
            for (int b = 0; b < 2; ++b)
#pragma unroll
                for (int m = 0; m < 4; ++m)
#pragma unroll
                    for (int n = 0; n < 2; ++n) acc[a][b][m][n] = (f32x4){0.f, 0.f, 0.f, 0.f};
        cur = nxt; cA = nA; cB = nB; ++ui;
        if constexpr (ALIGN_EPI) { if (wr == 1) PG8_BAR; }
    }
    PG8_WAIT_V(0);
    if constexpr (!ALIGN_EPI) { if (wr == 0) PG8_BAR; }
    PG8_BAR;
    if constexpr (Epi::AFTER_DRAIN) { E.fused(acc, cur, wr, wc, fr, fq, lds, wid, lane); S.done(cur); }
#undef PG8_SA
#undef PG8_SB
#undef PG8_STAGE
#undef PG8_LDA
#undef PG8_LDB
#undef PG8_MMA
#undef PG8_WAIT_V
#undef PG8_WAIT_L
#undef PG8_BAR
#undef PG8_SCHED
}
}
#define LAS __attribute__((address_space(3)))
#define DI __device__ __forceinline__
typedef unsigned short bf16;
typedef short bf16x8 __attribute__((ext_vector_type(8)));
typedef short s16x4 __attribute__((ext_vector_type(4)));
typedef float f32x4 __attribute__((ext_vector_type(4)));
typedef float f32x2 __attribute__((ext_vector_type(2)));
typedef float f32x16 __attribute__((ext_vector_type(16)));
typedef unsigned u32x4 __attribute__((ext_vector_type(4)));
typedef unsigned u32x2 __attribute__((ext_vector_type(2)));
typedef __bf16 bf16x2_t __attribute__((ext_vector_type(2)));
typedef short v4i16_t __attribute__((ext_vector_type(4)));

constexpr int NB = 8, SEQ = 4096, T = NB * SEQ, DM = 1024, NPHYS = 5632, DIN = 5416;
constexpr float C2 = 0.125f * 1.4426950408889634f;
constexpr float EPS = 1e-6f;
constexpr float NEGB = -1e30f;
constexpr size_t MiB = 1u << 20;
constexpr size_t O_WIN = 0, O_WUPN = 22 * MiB, O_WUPG = 24 * MiB, O_WOUT = 26 * MiB, O_WC1 = 30 * MiB, O_TAB = 34 * MiB, O_CBIAS = 35 * MiB,
    O_HB = 36 * MiB, O_QN = 100 * MiB, O_KS = 132 * MiB, O_KW = 140 * MiB, O_VS = 148 * MiB, O_VW = 156 * MiB, O_KCRAW = 164 * MiB, O_NZ = 181 * MiB,
    O_GQ = 213 * MiB, O_GK = 229 * MiB, O_GV = 245 * MiB, O_GR = 277 * MiB, O_MG = 309 * MiB, O_MISC = 437 * MiB, O_KCMP = 441 * MiB, O_UPD = 442 * MiB,
    O_DECAY = 506 * MiB, WS_END = 507 * MiB;
constexpr size_t O_Y = O_HB, O_OINTRA = O_HB, O_QG = O_HB + 32 * MiB, O_CPART = O_HB + 48 * MiB;
constexpr size_t O_ONSA = O_GQ, O_OGLA = O_GV, O_OUTB = O_GQ;
constexpr int KCR_ROWS = T + 64;
constexpr int LDS_BYTES = 139264;

#define LDS_WAIT() asm volatile("s_waitcnt lgkmcnt(0)" ::: "memory")
DI unsigned cvtpk(float lo, float hi) { f32x2 v = {lo, hi}; bf16x2_t b = __builtin_convertvector(v, bf16x2_t); return __builtin_bit_cast(unsigned, b); }
DI float bflo(unsigned w) { return __uint_as_float(w << 16); }
DI float bfhi(unsigned w) { return __uint_as_float(w & 0xffff0000u); }
DI float bf2f(bf16 b) { return __uint_as_float(((unsigned)b) << 16); }
DI float sigmoidf_(float x) { return 1.f / (1.f + __expf(-x)); }
DI float siluf_(float x) { return x / (1.f + __expf(-x)); }
DI float wave_sum(float v) {
#pragma unroll
    for (int o = 1; o < 64; o <<= 1) v += __shfl_xor(v, o);
    return v;
}
DI int crow(int reg, int hi) { return (reg & 3) + 8 * (reg >> 2) + 4 * hi; }
#define MFMA32(a, b, c) __builtin_amdgcn_mfma_f32_32x32x16_bf16((a), (b), (c), 0, 0, 0)
DI s16x4 vtr(const LAS unsigned char* p) { return __builtin_bit_cast(s16x4, __builtin_amdgcn_ds_read_tr16_b64_v4i16((LAS v4i16_t*)p)); }
DI bf16x8 cat8(s16x4 lo, s16x4 hi) { return __builtin_shufflevector(lo, hi, 0, 1, 2, 3, 4, 5, 6, 7); }
DI bf16x8 pack8(float a0, float a1, float a2, float a3, float a4, float a5, float a6, float a7) {
    u32x4 w; w.x = cvtpk(a0, a1); w.y = cvtpk(a2, a3); w.z = cvtpk(a4, a5); w.w = cvtpk(a6, a7); return __builtin_bit_cast(bf16x8, w);
}

struct Args { const float* in[16]; float* out; unsigned char* ws; };
struct Ctx {
    const Args* a;
    float* out;
    unsigned char* ws;
    int tid, lane, wid, G, vcu;
};
DI Ctx launder(const Ctx& c0) { Ctx c = c0; asm volatile("" : "+s"(c.ws), "+s"(c.out), "+v"(c.tid)); return c; }
enum { I_X = 0, I_GPRE, I_WIN, I_CPK, I_CW1K, I_CW2K, I_CPV, I_CW1V, I_CW2V, I_GWA, I_GBA, I_GNORM, I_WUPN, I_WUPG, I_WOUT, I_GPOST };

DI void map_block(int pb, int& src0, int& nvalid) {
    const int tile = pb >> 3, blk = pb & 7; nvalid = 32;
    if (tile <= 1) src0 = tile * 256 + blk * 32;
    else if (tile == 2) { const int bj = blk >> 2, hh = blk & 3; src0 = (hh < 2 ? 768 + hh * 64 : 1024 + (hh - 2) * 64) + 32 * bj; }
    else if (tile == 3) src0 = blk < 4 ? 512 + 32 * blk : 640 + 32 * (blk - 4);
    else if (tile == 4) src0 = blk < 4 ? 896 + 32 * blk : 1152 + 32 * (blk - 4);
    else if (tile <= 6) src0 = 1304 + (tile - 5) * 256 + 32 * blk;
    else if (tile == 7) src0 = 1816 + 32 * blk;
    else if (tile == 8) src0 = 2072 + 32 * blk;
    else if (tile <= 10) src0 = 2328 + (tile - 9) * 256 + 32 * blk;
    else if (tile <= 12) src0 = 2856 + (tile - 11) * 256 + 32 * blk;
    else if (tile <= 20) src0 = 3368 + (tile - 13) * 256 + 32 * blk;
    else { if (blk == 0) { src0 = 1280; nvalid = 24; } else if (blk == 1) { src0 = 2840; nvalid = 16; } else { src0 = 0; nvalid = 0; } }
}
DI void transpose_item(const float* W, int ldw, int src0, int nvalid, int ldk, bf16* WT, int dst_row0, LAS float* scr, int kb, int lane) {
    const int k0 = 64 * kb, n = lane & 31;
    float tv[32];
#pragma unroll
    for (int i = 0; i < 32; ++i) { const int kk = 2 * i + (lane >> 5); tv[i] = 0.f; if (n < nvalid) tv[i] = W[(size_t)(k0 + kk) * ldw + src0 + n]; }
#pragma unroll
    for (int i = 0; i < 32; ++i) { const int kk = 2 * i + (lane >> 5); scr[kk * 33 + n] = tv[i]; }
    LDS_WAIT();
    const int c = lane & 7;
#pragma unroll
    for (int j = 0; j < 4; ++j) { const int nn = (lane >> 3) + 8 * j; const LAS float* s = scr + (8 * c) * 33 + nn;
        u32x4 o; o.x = cvtpk(s[0 * 33], s[1 * 33]); o.y = cvtpk(s[2 * 33], s[3 * 33]); o.z = cvtpk(s[4 * 33], s[5 * 33]); o.w = cvtpk(s[6 * 33], s[7 * 33]);
        *(u32x4*)(WT + (size_t)(dst_row0 + nn) * ldk + k0 + 8 * c) = o; }
    LDS_WAIT();
}
DI void rms_row_bf16(const float* xrow, const float* g, bf16* orow, int lane) {
    f32x4 v[4]; float s = 0.f;
#pragma unroll
    for (int j = 0; j < 4; ++j) { v[j] = ((const f32x4*)xrow)[lane + 64 * j]; s += (v[j].x * v[j].x + v[j].y * v[j].y) + (v[j].z * v[j].z + v[j].w * v[j].w); }
    const float r = 1.f / sqrtf(wave_sum(s) * (1.f / 1024.f) + EPS);
#pragma unroll
    for (int j = 0; j < 4; ++j) { const f32x4 gg = ((const f32x4*)g)[lane + 64 * j]; u32x2 o; o.x = cvtpk(v[j].x * r * gg.x, v[j].y * r * gg.y); o.y = cvtpk(v[j].z * r * gg.z, v[j].w * r * gg.w);
        ((u32x2*)orow)[lane + 64 * j] = o; }
}
DI void phase0(const Ctx& c0, LAS unsigned char* lds) {
    const Ctx c = launder(c0);
    LAS float* scr = (LAS float*)(lds + c.wid * 16384);
    const int gw = blockIdx.x * 8 + c.wid, NGW = c.G * 8;
    constexpr int PER_L = 2816 + 256 + 256 + 512 + 256 + 256;
    for (int it = gw; it < 2 * PER_L; it += NGW) {
        const int l = it / PER_L; int r = it % PER_L;
        if (r < 2816) { const int pb = r >> 4, kb = r & 15; int src0, nv; map_block(pb, src0, nv);
            transpose_item(c.a->in[I_WIN] + (size_t)l * 1024 * DIN, DIN, src0, nv, 1024, (bf16*)(c.ws + O_WIN + (size_t)l * 11 * MiB), pb * 32, scr, kb, c.lane); continue; }
        r -= 2816;
        if (r < 256) { transpose_item(c.a->in[I_WUPN] + (size_t)l * 512 * 1024, 1024, (r & 31) * 32, 32, 512, (bf16*)(c.ws + O_WUPN + (size_t)l * MiB), (r & 31) * 32, scr, r >> 5, c.lane); continue; }
        r -= 256;
        if (r < 256) { transpose_item(c.a->in[I_WUPG] + (size_t)l * 512 * 1024, 1024, (r & 31) * 32, 32, 512, (bf16*)(c.ws + O_WUPG + (size_t)l * MiB), (r & 31) * 32, scr, r >> 5, c.lane); continue; }
        r -= 256;
        if (r < 512) { transpose_item(c.a->in[I_WOUT] + (size_t)l * 1024 * 1024, 1024, (r & 31) * 32, 32, 1024, (bf16*)(c.ws + O_WOUT + (size_t)l * 2 * MiB), (r & 31) * 32, scr, r >> 5, c.lane); continue; }
        r -= 512;
        { const int kv = r >> 8; r &= 255; const int nb = r & 7, kb = r >> 3;
          transpose_item(c.a->in[kv ? I_CW1V : I_CW1K] + (size_t)l * 2048 * 128, 128, (nb & 3) * 32, nb < 4 ? 32 : 0, 2048, (bf16*)(c.ws + O_WC1 + (size_t)(l * 2 + kv) * MiB), nb * 32, scr, kb, c.lane); }
    }
    { float* ct = (float*)(c.ws + O_TAB); float* st = ct + 4096 * 32;
      for (int i = blockIdx.x * 512 + c.tid; i < 4096 * 32; i += c.G * 512) { const int pos = i >> 5, e = i & 31;
          const float inv = (float)pow(10000.0, -(double)e / 32.0); const float ang = (float)pos * inv;
          const double a = (double)ang; const double k = rint(a * 0.15915494309189535); const double rr = a - k * 6.283185307179586;
          ct[i] = cosf((float)rr); st[i] = sinf((float)rr); } }
    { float* cb = (float*)(c.ws + O_CBIAS);
      for (int o = gw; o < 512; o += NGW) { const int l = o >> 8, kv = (o >> 7) & 1, h = o & 127;
          const float* pos = c.a->in[kv ? I_CPV : I_CPK] + (size_t)l * 2048; const float* w1 = c.a->in[kv ? I_CW1V : I_CW1K] + (size_t)l * 2048 * 128;
          float s = 0.f;
          for (int i = 0; i < 32; ++i) { const int ld = c.lane + 64 * i; s += pos[ld] * w1[(size_t)ld * 128 + h]; }
          s = wave_sum(s); if (c.lane == 0) cb[o] = s; } }
    for (int m = gw; m < T; m += NGW) rms_row_bf16(c.a->in[I_X] + (size_t)m * DM, c.a->in[I_GPRE], (bf16*)(c.ws + O_HB) + (size_t)m * DM, c.lane);
}

struct EpiProj {
    static constexpr bool PERM = true, AFTER_DRAIN = false;
    unsigned char* ws;
    DI void operator()(const pg8::f32x4 (&acc)[2][2][4][2], const pg8::Unit& u, int wr, int wc, int fr, int fq) const {
        const int pn = u.pn; const int row0 = u.pm * 256 + wr * 64 + fr;
        if (pn == 2) {
            const float* ct = (const float*)(ws + O_TAB); const float* st = ct + 4096 * 32;
            bf16* dst = (bf16*)(ws + O_KS) + (size_t)wc * T * 64;
#pragma unroll
            for (int ai = 0; ai < 2; ++ai)
#pragma unroll
                for (int m = 0; m < 4; ++m) { const int row = row0 + ai * 128 + m * 16; const int pos = row & (SEQ - 1);
                    const f32x4 c0 = *(const f32x4*)(ct + pos * 32 + 8 * fq), c1 = *(const f32x4*)(ct + pos * 32 + 8 * fq + 4);
                    const f32x4 s0 = *(const f32x4*)(st + pos * 32 + 8 * fq), s1 = *(const f32x4*)(st + pos * 32 + 8 * fq + 4);
                    const f32x4 l0 = acc[ai][0][m][0], l1 = acc[ai][0][m][1], h0 = acc[ai][1][m][0], h1 = acc[ai][1][m][1];
                    const f32x4 ol0 = l0 * c0 - h0 * s0, ol1 = l1 * c1 - h1 * s1, oh0 = h0 * c0 + l0 * s0, oh1 = h1 * c1 + l1 * s1;
                    u32x4 w; w.x = cvtpk(ol0[0], ol0[1]); w.y = cvtpk(ol0[2], ol0[3]); w.z = cvtpk(ol1[0], ol1[1]); w.w = cvtpk(ol1[2], ol1[3]);
                    *(u32x4*)(dst + (size_t)row * 64 + 8 * fq) = w;
                    w.x = cvtpk(oh0[0], oh0[1]); w.y = cvtpk(oh0[2], oh0[3]); w.z = cvtpk(oh1[0], oh1[1]); w.w = cvtpk(oh1[2], oh1[3]);
                    *(u32x4*)(dst + (size_t)row * 64 + 32 + 8 * fq) = w; }
            return;
        }
        bf16* base; int ld; size_t gs = 64; float sc = 1.f;
        if (pn <= 1) { base = (bf16*)(ws + O_QN) + pn * 256; ld = 512; sc = C2; }
        else if (pn == 3) { base = (bf16*)(ws + O_KCRAW); ld = 64; gs = (size_t)KCR_ROWS * 64; }
        else if (pn == 4) { base = (bf16*)(ws + O_VS); ld = 64; gs = (size_t)T * 64; }
        else if (pn <= 6) { base = (bf16*)(ws + O_NZ) + (pn - 5) * 256; ld = 512; }
        else if (pn == 7) { base = (bf16*)(ws + O_GQ); ld = 256; }
        else if (pn == 8) { base = (bf16*)(ws + O_GK); ld = 256; }
        else if (pn <= 10) { base = (bf16*)(ws + O_GV) + (pn - 9) * 256; ld = 512; }
        else if (pn <= 12) { base = (bf16*)(ws + O_GR) + (pn - 11) * 256; ld = 512; }
        else if (pn <= 20) { base = (bf16*)(ws + O_MG) + (pn - 13) * 256; ld = 2048; }
        else { base = (bf16*)(ws + O_MISC); ld = 64; }
#pragma unroll
        for (int bj = 0; bj < 2; ++bj) {
            const int col = 128 * bj + 32 * wc + 8 * fq; const int grp = col >> 6, cin = col & 63;
            if (pn == 21 && grp > 0) continue;
            bf16* bp = base + (size_t)grp * gs + cin;
#pragma unroll
            for (int ai = 0; ai < 2; ++ai)
#pragma unroll
                for (int m = 0; m < 4; ++m) { const int row = row0 + ai * 128 + m * 16;
                    const f32x4 v0 = acc[ai][bj][m][0] * sc, v1 = acc[ai][bj][m][1] * sc;
                    u32x4 w; w.x = cvtpk(v0[0], v0[1]); w.y = cvtpk(v0[2], v0[3]); w.z = cvtpk(v1[0], v1[1]); w.w = cvtpk(v1[2], v1[3]);
                    *(u32x4*)(bp + (size_t)row * ld) = w; }
        }
    }
};
struct EpiCPart {
    static constexpr bool PERM = false, AFTER_DRAIN = false;
    float* dst;
    DI void operator()(const pg8::f32x4 (&acc)[2][2][4][2], const pg8::Unit& u, int wr, int wc, int fr, int fq) const {
        const int row0 = u.pm * 256 + wr * 64 + fr;
#pragma unroll
        for (int ai = 0; ai < 2; ++ai)
#pragma unroll
            for (int m = 0; m < 4; ++m) { const int row = row0 + ai * 128 + m * 16;
#pragma unroll
                for (int n = 0; n < 2; ++n) *(f32x4*)(dst + (size_t)row * 128 + 32 * wc + 16 * n + 4 * fq) = acc[ai][0][m][n]; }
    }
};
template <bool ADD> struct EpiUp {
    static constexpr bool PERM = true, AFTER_DRAIN = false;
    const bf16* mg; bf16* y;
    DI void operator()(const pg8::f32x4 (&acc)[2][2][4][2], const pg8::Unit& u, int wr, int wc, int fr, int fq) const {
        const int row0 = u.pm * 256 + wr * 64 + fr;
#pragma unroll
        for (int bj = 0; bj < 2; ++bj) { const int col = u.pn * 256 + 128 * bj + 32 * wc + 8 * fq;
#pragma unroll
            for (int ai = 0; ai < 2; ++ai)
#pragma unroll
                for (int m = 0; m < 4; ++m) { const int row = row0 + ai * 128 + m * 16;
                    const u32x4 g = *(const u32x4*)(mg + (size_t)row * 2048 + col);
                    const f32x4 a0 = acc[ai][bj][m][0], a1 = acc[ai][bj][m][1];
                    float v[8];
                    v[0] = sigmoidf_(bflo(g.x)) * a0[0]; v[1] = sigmoidf_(bfhi(g.x)) * a0[1]; v[2] = sigmoidf_(bflo(g.y)) * a0[2]; v[3] = sigmoidf_(bfhi(g.y)) * a0[3];
                    v[4] = sigmoidf_(bflo(g.z)) * a1[0]; v[5] = sigmoidf_(bfhi(g.z)) * a1[1]; v[6] = sigmoidf_(bflo(g.w)) * a1[2]; v[7] = sigmoidf_(bfhi(g.w)) * a1[3];
                    u32x4* yp = (u32x4*)(y + (size_t)row * 1024 + col);
                    if (ADD) { const u32x4 o = *yp; v[0] += bflo(o.x); v[1] += bfhi(o.x); v[2] += bflo(o.y); v[3] += bfhi(o.y); v[4] += bflo(o.z); v[5] += bfhi(o.z); v[6] += bflo(o.w); v[7] += bfhi(o.w); }
                    u32x4 w; w.x = cvtpk(v[0], v[1]); w.y = cvtpk(v[2], v[3]); w.z = cvtpk(v[4], v[5]); w.w = cvtpk(v[6], v[7]);
                    *yp = w; }
        }
    }
};
struct EpiPlain {
    static constexpr bool PERM = true, AFTER_DRAIN = false;
    bf16* O; int ldc;
    DI void operator()(const pg8::f32x4 (&acc)[2][2][4][2], const pg8::Unit& u, int wr, int wc, int fr, int fq) const {
        const int row0 = u.pm * 256 + wr * 64 + fr;
#pragma unroll
        for (int bj = 0; bj < 2; ++bj) { const int col = u.pn * 256 + 128 * bj + 32 * wc + 8 * fq;
#pragma unroll
            for (int ai = 0; ai < 2; ++ai)
#pragma unroll
                for (int m = 0; m < 4; ++m) { const int row = row0 + ai * 128 + m * 16;
                    const f32x4 v0 = acc[ai][bj][m][0], v1 = acc[ai][bj][m][1];
                    u32x4 w; w.x = cvtpk(v0[0], v0[1]); w.y = cvtpk(v0[2], v0[3]); w.z = cvtpk(v1[0], v1[1]); w.w = cvtpk(v1[2], v1[3]);
                    *(u32x4*)(O + (size_t)row * ldc + col) = w; }
        }
    }
};
struct OneUnit {
    int pm; bool has;
    DI bool next(int i, pg8::Unit& u) const { if (i > 0 || !has) return false; u.pm = pm; u.pn = 0; return true; }
    DI void a_ready(const pg8::Unit&) const {}
    DI void done(const pg8::Unit&) const {}
};
#define XB_TMO      128
#define XB_XCNT(j)  (256  + 64 * (j))
#define XB_XSUB(j)  (1280 + 64 * (j))
#define XB_XGEN(j)  (2304 + 64 * (j))
#define XB_TOP      3328
#define XB_TOPGEN   3392
#define XCD_BAR_WORDS 3456
#define XB_SPIN_CAP (1u << 18)

__device__ __forceinline__ unsigned xb_ld(unsigned* p)              { return __hip_atomic_load(p, __ATOMIC_RELAXED, __HIP_MEMORY_SCOPE_AGENT); }
__device__ __forceinline__ unsigned xb_add(unsigned* p, unsigned v) { return __hip_atomic_fetch_add(p, v, __ATOMIC_RELAXED, __HIP_MEMORY_SCOPE_AGENT); }
__device__ __forceinline__ unsigned xb_xcc_id() { return (unsigned)__builtin_amdgcn_s_getreg((3 << 11) | 20) & 0xFu; }
#define XB_SPIN(cond, bar) do { unsigned _sp = 0; while (cond) { __builtin_amdgcn_s_sleep(1); \
    if ((++_sp & 255u) == 0u) { if (xb_ld(&(bar)[XB_TMO])) break; if (_sp > XB_SPIN_CAP) { atomicAdd(&(bar)[XB_TMO], 1u); break; } } } } while (0)

struct XcdBarrier {
    unsigned* bar; unsigned x;
    volatile LAS unsigned* st;
};

__device__ __forceinline__ XcdBarrier xcd_barrier_post(unsigned* bar, volatile LAS unsigned* st) {
    XcdBarrier b; b.bar = bar; b.x = xb_xcc_id(); b.st = st;
    if (threadIdx.x == 0) (void)xb_add(&bar[XB_XCNT(b.x)], 1u);
    return b;
}
__device__ __forceinline__ void xcd_barrier_complete(unsigned* bar, unsigned x, unsigned& nloc, unsigned& nx) {
    const unsigned G = gridDim.x * gridDim.y * gridDim.z;
    unsigned sum, cnt, mine, sp = 0u;
    for (;;) {
        sum = 0u; cnt = 0u; mine = 0u;
#pragma unroll
        for (unsigned j = 0; j < 16; ++j) { const unsigned c = xb_ld(&bar[XB_XCNT(j)]); sum += c; cnt += (c > 0u) ? 1u : 0u; mine = (j == x) ? c : mine; }
        if (sum == G) break;
        __builtin_amdgcn_s_sleep(1);
        if ((++sp & 255u) == 0u) { if (xb_ld(&bar[XB_TMO])) break; if (sp > XB_SPIN_CAP) { atomicAdd(&bar[XB_TMO], 1u); break; } }
    }
    nloc = mine > 0u ? mine : 1u; nx = cnt > 0u ? cnt : 1u;
}

__device__ __forceinline__ void xcd_barrier(const XcdBarrier& b) {
    asm volatile("s_waitcnt vmcnt(0)" ::: "memory");
    __syncthreads();
    if (threadIdx.x == 0) {
        unsigned* bar = b.bar;
        __builtin_amdgcn_s_waitcnt(0);
        unsigned nloc = b.st[0], nx = b.st[1];
        if (nloc == 0u) { xcd_barrier_complete(bar, b.x, nloc, nx); b.st[0] = nloc; b.st[1] = nx; }
        const unsigned old = xb_add(&bar[XB_XSUB(b.x)], 1u);
        const unsigned gen = old / nloc;
        if (old + 1u == (gen + 1u) * nloc) {
            __builtin_amdgcn_fence(__ATOMIC_RELEASE, "agent");
            asm volatile("s_waitcnt vmcnt(0)" ::: "memory");
            const unsigned og = xb_add(&bar[XB_TOP], 1u);
            const unsigned tg = og / nx;
            if (og + 1u == (tg + 1u) * nx) xb_add(&bar[XB_TOPGEN], 1u);
            else XB_SPIN(xb_ld(&bar[XB_TOPGEN]) == tg, bar);
            __builtin_amdgcn_fence(__ATOMIC_ACQUIRE, "agent");
            xb_add(&bar[XB_XGEN(b.x)], 1u);
            asm volatile("s_waitcnt vmcnt(0)" ::: "memory");
        } else {
            XB_SPIN(xb_ld(&bar[XB_XGEN(b.x)]) == gen, bar);
            __builtin_amdgcn_fence(__ATOMIC_ACQUIRE, "agent");
            asm volatile("s_waitcnt vmcnt(0)" ::: "memory");
        }
    }
    __syncthreads();
}
constexpr int G1_LA = 0, G1_PART = 16640, G1_QGT = 18688, G1_KGT = G1_QGT + 8192, G1_KU = G1_KGT + 8192, G1_VI = G1_KU + 8192, G1_END = G1_VI + 16384;
DI void gla_stage1(const Ctx& c0, int layer, int unit, LAS unsigned char* lds) {
    const Ctx c = launder(c0);
    const int tid = c.tid, lane = c.lane, wid = c.wid, r = lane & 31, hi = lane >> 5;
    const int bh = unit >> 6, n = unit & 63, b = bh >> 2, h = bh & 3;
    const size_t row0 = (size_t)b * SEQ + n * 64;
    LAS float* LA = (LAS float*)(lds + G1_LA); LAS float* PART = (LAS float*)(lds + G1_PART);
    const bf16* gq = (const bf16*)(c.ws + O_GQ); const bf16* gk = (const bf16*)(c.ws + O_GK); const bf16* gv = (const bf16*)(c.ws + O_GV);
    const bf16* misc = (const bf16*)(c.ws + O_MISC);
    const float* Wa = c.a->in[I_GWA] + (size_t)layer * 16 * 256 + h * 64; const float* ba = c.a->in[I_GBA] + (size_t)layer * 256 + h * 64;
    const int cc = tid >> 3, ch = tid & 7;
#pragma unroll
    for (int it = 0; it < 2; ++it) { const int idx = tid + 512 * it, vc_ = idx & 15, c_ = idx >> 4;
        const u32x4 v = *(const u32x4*)(gv + (row0 + c_) * 512 + h * 128 + vc_ * 8);
        *(LAS u32x4*)(lds + G1_VI + (vc_ >> 2) * 4096 + c_ * 64 + (vc_ & 3) * 16) = v; }
    {
        float ga[16];
        { const u32x4 g0 = *(const u32x4*)(misc + (row0 + cc) * 64 + 32), g1 = *(const u32x4*)(misc + (row0 + cc) * 64 + 40);
          ga[0] = bflo(g0.x); ga[1] = bfhi(g0.x); ga[2] = bflo(g0.y); ga[3] = bfhi(g0.y); ga[4] = bflo(g0.z); ga[5] = bfhi(g0.z); ga[6] = bflo(g0.w); ga[7] = bfhi(g0.w);
          ga[8] = bflo(g1.x); ga[9] = bfhi(g1.x); ga[10] = bflo(g1.y); ga[11] = bfhi(g1.y); ga[12] = bflo(g1.z); ga[13] = bfhi(g1.z); ga[14] = bflo(g1.w); ga[15] = bfhi(g1.w); }
        f32x4 a0 = *(const f32x4*)(ba + 8 * ch), a1 = *(const f32x4*)(ba + 8 * ch + 4);
        const float* wap = Wa + 8 * ch; asm volatile("" : "+v"(wap));
#pragma unroll
        for (int rr = 0; rr < 16; ++rr) { const f32x4 w0 = *(const f32x4*)(wap + rr * 256), w1 = *(const f32x4*)(wap + rr * 256 + 4); a0 += w0 * ga[rr]; a1 += w1 * ga[rr]; }
#pragma unroll
        for (int j = 0; j < 8; ++j) { const float x = j < 4 ? a0[j & 3] : a1[j & 3];
            const float ls = fminf(x, 0.f) - __logf(1.f + __expf(-fabsf(x)));
            LA[cc * 65 + 8 * ch + j] = ls * (1.f / 16.f); }
    }
    __syncthreads();
    {
        const int d = tid & 63, part = tid >> 6; float v[8]; float run = 0.f;
#pragma unroll
        for (int j = 0; j < 8; ++j) { run += LA[(8 * part + j) * 65 + d]; v[j] = run; }
        PART[part * 64 + d] = run;
        __syncthreads();
        float off = 0.f;
#pragma unroll
        for (int p = 0; p < 8; ++p) off += (p < part) ? PART[p * 64 + d] : 0.f;
#pragma unroll
        for (int j = 0; j < 8; ++j) LA[(8 * part + j) * 65 + d] = v[j] + off;
    }
    __syncthreads();
    {
        const u32x4 qw = *(const u32x4*)(gq + (row0 + cc) * 256 + h * 64 + 8 * ch), kw = *(const u32x4*)(gk + (row0 + cc) * 256 + h * 64 + 8 * ch);
        float q[8], k[8];
        q[0] = bflo(qw.x); q[1] = bfhi(qw.x); q[2] = bflo(qw.y); q[3] = bfhi(qw.y); q[4] = bflo(qw.z); q[5] = bfhi(qw.z); q[6] = bflo(qw.w); q[7] = bfhi(qw.w);
        k[0] = bflo(kw.x); k[1] = bfhi(kw.x); k[2] = bflo(kw.y); k[3] = bfhi(kw.y); k[4] = bflo(kw.z); k[5] = bfhi(kw.z); k[6] = bflo(kw.w); k[7] = bfhi(kw.w);
        float qg[8], kg[8], ku[8];
#pragma unroll
        for (int j = 0; j < 8; ++j) { const float bb = LA[cc * 65 + 8 * ch + j], bl = LA[63 * 65 + 8 * ch + j];
            const float en = __expf(-bb); qg[j] = q[j] * 0.125f * __expf(bb); kg[j] = k[j] * en; ku[j] = k[j] * __expf(bl - bb); }
        const bf16x8 qv = pack8(qg[0], qg[1], qg[2], qg[3], qg[4], qg[5], qg[6], qg[7]);
        *(LAS bf16x8*)(lds + G1_QGT + ch * 1024 + cc * 16) = qv;
        *(bf16x8*)((bf16*)(c.ws + O_QG) + (row0 + cc) * 256 + h * 64 + 8 * ch) = qv;
        *(LAS bf16x8*)(lds + G1_KGT + ch * 1024 + cc * 16) = pack8(kg[0], kg[1], kg[2], kg[3], kg[4], kg[5], kg[6], kg[7]);
        *(LAS bf16x8*)(lds + G1_KU + (ch >> 2) * 4096 + cc * 64 + (ch & 3) * 16) = pack8(ku[0], ku[1], ku[2], ku[3], ku[4], ku[5], ku[6], ku[7]);
        if (tid < 64) ((float*)(c.ws + O_DECAY))[(size_t)unit * 64 + tid] = __expf(LA[63 * 65 + tid]);
    }
    __syncthreads();
    {
        const int cb = wid & 1, vb = wid >> 1;
        const LAS unsigned char* kb = lds + G1_KGT + hi * 1024 + r * 16;
        const LAS unsigned char* qb = lds + G1_QGT + hi * 1024 + (r + 32 * cb) * 16;
        bf16x8 qf[4];
#pragma unroll
        for (int s = 0; s < 4; ++s) qf[s] = *(const LAS bf16x8*)(qb + s * 2048);
        const int cl = 32 * cb + r;
        bf16x8 pa[4];
#pragma unroll
        for (int jb = 0; jb < 2; ++jb) {
            f32x16 x = {};
            if (jb <= cb) {
#pragma unroll
                for (int s = 0; s < 4; ++s) { const bf16x8 a = *(const LAS bf16x8*)(kb + s * 2048 + jb * 512); x = MFMA32(a, qf[s], x); }
#pragma unroll
                for (int rg = 0; rg < 16; ++rg) { const int j = 32 * jb + crow(rg, hi); if (j > cl) x[rg] = 0.f; }
            }
            pa[2 * jb] = pack8(x[0], x[1], x[2], x[3], x[4], x[5], x[6], x[7]);
            pa[2 * jb + 1] = pack8(x[8], x[9], x[10], x[11], x[12], x[13], x[14], x[15]);
        }
        const int troff = (4 * hi + ((lane & 15) >> 2)) * 64 + ((lane >> 4) & 1) * 32 + (lane & 3) * 8;
        const LAS unsigned char* vbp = lds + G1_VI + vb * 4096 + troff;
        const LAS unsigned char* kup = lds + G1_KU + cb * 4096 + troff;
        f32x16 o = {}, uacc = {};
#pragma unroll
        for (int s = 0; s < 4; ++s) {
            const bf16x8 vf = cat8(vtr(vbp + s * 1024), vtr(vbp + s * 1024 + 512));
            const bf16x8 kf = cat8(vtr(kup + s * 1024), vtr(kup + s * 1024 + 512));
            o = MFMA32(pa[s], vf, o);
            uacc = MFMA32(kf, vf, uacc);
        }
        bf16* oip = (bf16*)(c.ws + O_OINTRA) + (row0 + 32 * cb + 4 * hi) * 512 + h * 128 + 32 * vb + r; asm volatile("" : "+v"(oip));
        float* upp = (float*)(c.ws + O_UPD) + (size_t)unit * 8192 + (32 * cb + 4 * hi) * 128 + 32 * vb + r; asm volatile("" : "+v"(upp));
#pragma unroll
        for (int rg = 0; rg < 16; ++rg) { const int ro = (rg & 3) + 8 * (rg >> 2);
            oip[ro * 512] = (bf16)(cvtpk(o[rg], 0.f) & 0xffffu);
            upp[ro * 128] = uacc[rg]; }
    }
    __syncthreads();
}
DI void gla_stage2(const Ctx& c) {
    float* upd = (float*)(c.ws + O_UPD); const float* dec = (const float*)(c.ws + O_DECAY);
    for (int e = blockIdx.x * 512 + c.tid; e < 32 * 4096; e += c.G * 512) {
        const int bh = e >> 12, pp = e & 4095, d = pp >> 6, v2 = (pp & 63) * 2;
        float* p = upd + (size_t)bh * 64 * 8192 + d * 128 + v2; const float* dp = dec + (size_t)bh * 64 * 64 + d;
        float s0 = 0.f, s1 = 0.f;
        for (int n0 = 0; n0 < 64; n0 += 16) {
            f32x2 u[16]; float dd[16];
#pragma unroll
            for (int j = 0; j < 16; ++j) { u[j] = *(const f32x2*)(p + (size_t)(n0 + j) * 8192); dd[j] = dp[(n0 + j) * 64]; }
#pragma unroll
            for (int j = 0; j < 16; ++j) { *(f32x2*)(p + (size_t)(n0 + j) * 8192) = (f32x2){s0, s1}; s0 = dd[j] * s0 + u[j].x; s1 = dd[j] * s1 + u[j].y; }
        }
    }
}
constexpr int G3_PITCH = 272, G3_BYTES = 32 * G3_PITCH;
DI void g3_tile_in(const bf16* g, LAS unsigned char* R, int lane) {
#pragma unroll
    for (int it = 0; it < 8; ++it) { const int row = 4 * it + (lane >> 4), ch = lane & 15;
        *(LAS u32x4*)(R + row * G3_PITCH + ch * 16) = *(const u32x4*)(g + (size_t)row * 512 + ch * 8); }
    LDS_WAIT();
}
DI void g3_tile_out(bf16* g, const LAS unsigned char* R, int lane) {
    LDS_WAIT();
#pragma unroll
    for (int it = 0; it < 8; ++it) { const int row = 4 * it + (lane >> 4), ch = lane & 15;
        *(u32x4*)(g + (size_t)row * 512 + ch * 8) = *(const LAS u32x4*)(R + row * G3_PITCH + ch * 16); }
    LDS_WAIT();
}
DI void gla_stage3(const Ctx& c0, int layer, int unit, int cb, LAS unsigned char* lds) {
    const Ctx c = launder(c0);
    const int lane = c.lane, r = lane & 31, hi = lane >> 5;
    const int bh = unit >> 6, n = unit & 63, b = bh >> 2, h = bh & 3;
    const size_t row0 = (size_t)b * SEQ + n * 64 + 32 * cb;
    LAS unsigned char* R = lds + c.wid * G3_BYTES;
    const LAS unsigned char* Re = R + (4 * hi) * G3_PITCH + r * 2;
    const bf16* qgp = (const bf16*)(c.ws + O_QG) + (row0 + r) * 256 + h * 64 + 8 * hi;
    const float* sp = (const float*)(c.ws + O_UPD) + (size_t)unit * 8192;
    const float* gn = c.a->in[I_GNORM] + (size_t)layer * 128;
    bf16x8 qf[4];
#pragma unroll
    for (int s = 0; s < 4; ++s) qf[s] = *(const bf16x8*)(qgp + 16 * s);
    f32x16 o[4];
#pragma unroll
    for (int vb = 0; vb < 4; ++vb) {
        o[vb] = f32x16{};
#pragma unroll
        for (int s = 0; s < 4; ++s) { const float* s0 = sp + (size_t)(16 * s + 8 * hi) * 128 + 32 * vb + r;
            const bf16x8 bfv = pack8(s0[0], s0[128], s0[256], s0[384], s0[512], s0[640], s0[768], s0[896]);
            o[vb] = MFMA32(qf[s], bfv, o[vb]); }
        asm volatile("" ::: "memory");
    }
    g3_tile_in((const bf16*)(c.ws + O_OINTRA) + row0 * 512 + h * 128, R, lane);
#pragma unroll
    for (int vb = 0; vb < 4; ++vb) {
#pragma unroll
        for (int rg = 0; rg < 16; ++rg) o[vb][rg] += bf2f(*(const LAS bf16*)(Re + ((rg & 3) + 8 * (rg >> 2)) * G3_PITCH + 64 * vb));
        asm volatile("" ::: "memory");
    }
    float rs[16];
#pragma unroll
    for (int rg = 0; rg < 16; ++rg) { float ss = o[0][rg] * o[0][rg] + o[1][rg] * o[1][rg] + o[2][rg] * o[2][rg] + o[3][rg] * o[3][rg];
        ss += __shfl_xor(ss, 1); ss += __shfl_xor(ss, 2); ss += __shfl_xor(ss, 4); ss += __shfl_xor(ss, 8); ss += __shfl_xor(ss, 16);
        rs[rg] = 1.f / sqrtf(ss * (1.f / 128.f) + EPS); }
    LDS_WAIT();
    g3_tile_in((const bf16*)(c.ws + O_GR) + row0 * 512 + h * 128, R, lane);
#pragma unroll
    for (int vb = 0; vb < 4; ++vb) { const float g = gn[32 * vb + r];
#pragma unroll
        for (int rg = 0; rg < 16; ++rg) { LAS bf16* e = (LAS bf16*)(R + (4 * hi) * G3_PITCH + r * 2 + ((rg & 3) + 8 * (rg >> 2)) * G3_PITCH + 64 * vb);
            const float z = bf2f(*e);
            *e = (bf16)(cvtpk(o[vb][rg] * rs[rg] * g * siluf_(z), 0.f) & 0xffffu); }
        asm volatile("" ::: "memory"); }
    g3_tile_out((bf16*)(c.ws + O_OGLA) + row0 * 512 + h * 128, R, lane);
}
constexpr int A_KT = 0, A_VT = 16384, A_WSF = 32768, A_IMP = 36864, A_SEL = A_IMP + 65536, A_OC = A_SEL + 512, A_END = A_OC + 32768;
struct ASt { float m, l; f32x16 o0, o1; };
struct TileRegs { u32x4 k, v; };
DI TileRegs tile_fetch(const bf16* Kg, const bf16* Vg, int tok0, int tid) {
    TileRegs t; const size_t off = (size_t)(tok0 + (tid >> 3)) * 64 + (tid & 7) * 8;
    t.k = *(const u32x4*)(Kg + off); t.v = *(const u32x4*)(Vg + off); return t;
}
DI void tile_stage(const TileRegs& t, LAS unsigned char* lds, int buf, int tid) {
    const int kv = tid >> 3, ch = tid & 7;
    *(LAS u32x4*)(lds + A_KT + buf * 8192 + ch * 1024 + ((kv ^ (2 * ch)) * 16)) = t.k;
    *(LAS u32x4*)(lds + A_VT + buf * 8192 + (ch >> 2) * 4096 + kv * 64 + (ch & 3) * 16) = t.v;
}
template <bool CMP> DI void tile_compute(LAS unsigned char* lds, int buf, const bf16x8 (&q)[4], int lo, int hv, ASt& st, f32x16& imp0, f32x16& imp1, int jt, LAS float* wsf, int lane) {
    const int r = lane & 31, hi = lane >> 5;
    const LAS unsigned char* kb0 = lds + A_KT + buf * 8192 + hi * 1024;
    f32x16 p0 = {}, p1 = {};
#pragma unroll
    for (int s = 0; s < 4; ++s) { const LAS unsigned char* kb = kb0 + ((r ^ (4 * s + 2 * hi)) * 16);
        const bf16x8 a0 = *(const LAS bf16x8*)(kb + s * 2048), a1 = *(const LAS bf16x8*)(kb + s * 2048 + 512);
        p0 = MFMA32(a0, q[s], p0); p1 = MFMA32(a1, q[s], p1); }
    const bool dead = lo > hv;
    const bool part = !dead && (lo > 0 || hv < 63);
    const bool anyPart = __builtin_amdgcn_ballot_w64(part) != 0ull;
    if (anyPart) {
#pragma unroll
        for (int rg = 0; rg < 16; ++rg) { const int k0 = crow(rg, hi), k1 = k0 + 32;
            p0[rg] = (k0 >= lo && k0 <= hv) ? p0[rg] : NEGB; p1[rg] = (k1 >= lo && k1 <= hv) ? p1[rg] : NEGB; }
    }
    float mx = __builtin_fmaxf(p0[0], p1[0]);
#pragma unroll
    for (int rg = 1; rg < 16; ++rg) mx = __builtin_fmaxf(__builtin_fmaxf(mx, p0[rg]), p1[rg]);
    if (!anyPart && dead) mx = NEGB;
    mx = __builtin_fmaxf(mx, __shfl_xor(mx, 32));
    const float mnew = fmaxf(st.m, mx);
    const float alpha = __builtin_amdgcn_exp2f(st.m - mnew);
    st.m = mnew;
    float sum = 0.f;
    const float msub = (!anyPart && dead) ? 1e30f : mnew;
#pragma unroll
    for (int rg = 0; rg < 16; ++rg) { p0[rg] = __builtin_amdgcn_exp2f(p0[rg] - msub); p1[rg] = __builtin_amdgcn_exp2f(p1[rg] - msub); sum += p0[rg] + p1[rg]; }
    st.l = st.l * alpha + sum;
    if (__builtin_amdgcn_ballot_w64(alpha != 1.f) != 0ull) {
        if (hi == 0) wsf[r] = alpha;
        LDS_WAIT();
#pragma unroll
        for (int g4 = 0; g4 < 4; ++g4) { const f32x4 f = *(const LAS f32x4*)(wsf + 8 * g4 + 4 * hi);
#pragma unroll
            for (int k = 0; k < 4; ++k) { st.o0[4 * g4 + k] *= f[k]; st.o1[4 * g4 + k] *= f[k]; if (CMP) { imp0[4 * g4 + k] *= f[k]; imp1[4 * g4 + k] *= f[k]; } } }
        LDS_WAIT();
    }
    bf16x8 pa[4];
    pa[0] = pack8(p0[0], p0[1], p0[2], p0[3], p0[4], p0[5], p0[6], p0[7]); pa[1] = pack8(p0[8], p0[9], p0[10], p0[11], p0[12], p0[13], p0[14], p0[15]);
    pa[2] = pack8(p1[0], p1[1], p1[2], p1[3], p1[4], p1[5], p1[6], p1[7]); pa[3] = pack8(p1[8], p1[9], p1[10], p1[11], p1[12], p1[13], p1[14], p1[15]);
    const LAS unsigned char* vb = lds + A_VT + buf * 8192 + (4 * hi + ((lane & 15) >> 2)) * 64 + ((lane >> 4) & 1) * 32 + (lane & 3) * 8;
#pragma unroll
    for (int s = 0; s < 4; ++s) {
        const bf16x8 v0 = cat8(vtr(vb + s * 1024), vtr(vb + s * 1024 + 512));
        const bf16x8 v1 = cat8(vtr(vb + 4096 + s * 1024), vtr(vb + 4096 + s * 1024 + 512));
        st.o0 = MFMA32(pa[s], v0, st.o0); st.o1 = MFMA32(pa[s], v1, st.o1);
    }
    if (CMP) {
#pragma unroll
        for (int s = 0; s < 4; ++s) {
            bf16x8 w0, w1;
#pragma unroll
            for (int j = 0; j < 8; ++j) { const int jj = 64 * jt + 16 * s + 8 * (j >> 2) + 4 * hi + (j & 3);
                const int n0 = r, n1 = 32 + r;
                w0[j] = (jj >= 4 * n0 - 1 && jj <= 4 * n0 + 3) ? (short)0x3F80 : (short)0;
                w1[j] = (jj >= 4 * n1 - 1 && jj <= 4 * n1 + 3) ? (short)0x3F80 : (short)0; }
            imp0 = MFMA32(pa[s], w0, imp0); imp1 = MFMA32(pa[s], w1, imp1); asm volatile("" ::: "memory");
        }
    }
}
DI void branch_fold(ASt& st, float gate, bool may_be_empty, LAS float* wsf, int lane) {
    const int r = lane & 31, hi = lane >> 5;
    const float lt = st.l + __shfl_xor(st.l, 32);
    float inv = 1.f / lt; if (may_be_empty && !(st.m > -1e29f)) inv = 0.f;
    if (hi == 0) { wsf[r] = inv * gate; wsf[32 + r] = inv; }
    LDS_WAIT();
#pragma unroll
    for (int g4 = 0; g4 < 4; ++g4) { const f32x4 f = *(const LAS f32x4*)(wsf + 8 * g4 + 4 * hi);
#pragma unroll
        for (int k = 0; k < 4; ++k) { st.o0[4 * g4 + k] *= f[k]; st.o1[4 * g4 + k] *= f[k]; } }
}
DI void nsa_unit(const Ctx& c0, int b, int g, int i, LAS unsigned char* lds) {
    const Ctx c = launder(c0);
    const int tid = c.tid, lane = c.lane, wid = c.wid, r = lane & 31, hi = lane >> 5;
    const int hl = wid >> 1, qh = wid & 1, head = g * 4 + hl, ql = 32 * qh + r, t = i * 64 + ql;
    const size_t row = (size_t)b * SEQ + t;
    LAS float* wsf = (LAS float*)(lds + A_WSF) + wid * 64;
    LAS float* IMP = (LAS float*)(lds + A_IMP);
    LAS unsigned long long* SEL = (LAS unsigned long long*)(lds + A_SEL);
    const bf16* misc = (const bf16*)(c.ws + O_MISC);
    bf16x8 qn[4];
    { const bf16* qp = (const bf16*)(c.ws + O_QN) + row * 512 + head * 64 + 8 * hi;
#pragma unroll
      for (int s = 0; s < 4; ++s) qn[s] = *(const bf16x8*)(qp + 16 * s); }
    const float g_c = sigmoidf_(bf2f(misc[row * 64 + head * 3 + 0])), g_s = sigmoidf_(bf2f(misc[row * 64 + head * 3 + 1])), g_w = sigmoidf_(bf2f(misc[row * 64 + head * 3 + 2]));
#ifdef PROBE_NOC
    const float g_c2 = 0.f;
#else
    const float g_c2 = g_c;
#endif
#ifdef PROBE_NOS
    const float g_s2 = 0.f;
#else
    const float g_s2 = g_s;
#endif
#ifdef PROBE_NOW
    const float g_w2 = 0.f;
#else
    const float g_w2 = g_w;
#endif
    f32x16 dum0 = {}, dum1 = {};
    LAS float* OACC = (LAS float*)(lds + A_IMP) + wid * 2048 + lane;
    LAS unsigned* OC = (LAS unsigned*)(lds + A_OC) + wid * 1024 + lane;
    f32x16 ca0, ca1;
#ifndef SKN_CMP
    {
        const bf16* Kg = (const bf16*)(c.ws + O_KCMP) + ((size_t)(0 + g) * 2048 + b * 256) * 64;
        const bf16* Vg = (const bf16*)(c.ws + O_KCMP) + ((size_t)(2 + g) * 2048 + b * 256) * 64;
        const int nt = (4 * i + 3 + 63) >> 6;
        const int jmax = (t - 31) >> 4;
        ASt st; st.m = NEGB; st.l = 0.f; st.o0 = f32x16{}; st.o1 = f32x16{};
        f32x16 imp0 = {}, imp1 = {};
        TileRegs tr = tile_fetch(Kg, Vg, 0, tid);
        for (int k = 0; k < nt; ++k) {
            tile_stage(tr, lds, k & 1, tid);
            __syncthreads();
            if (k + 1 < nt) tr = tile_fetch(Kg, Vg, 64 * (k + 1), tid);
            int hv = jmax - 64 * k; hv = hv > 63 ? 63 : hv; const int lo = hv < 0 ? 64 : 0;
            tile_compute<true>(lds, k & 1, qn, lo, hv, st, imp0, imp1, k, wsf, lane);
        }
        branch_fold(st, g_c2, true, wsf, lane);
#pragma unroll
        for (int rg = 0; rg < 16; ++rg) OC[rg * 64] = cvtpk(st.o0[rg], st.o1[rg]);
#pragma unroll
        for (int g4 = 0; g4 < 4; ++g4) { const f32x4 f = *(const LAS f32x4*)(wsf + 32 + 8 * g4 + 4 * hi);
#pragma unroll
            for (int k = 0; k < 4; ++k) { const int qq = 32 * qh + 8 * g4 + 4 * hi + k;
                IMP[(hl * 64 + qq) * 64 + r] = imp0[4 * g4 + k] * f[k]; IMP[(hl * 64 + qq) * 64 + 32 + r] = imp1[4 * g4 + k] * f[k]; } }
        __syncthreads();
    }
#endif
    unsigned long long mysel, um;
    {
        const unsigned long long validm = (i >= 63) ? ~0ull : ((1ull << (i + 1)) - 1ull);
        if (i >= 16) {
            for (int qq = 8 * wid; qq < 8 * wid + 8; ++qq) {
                const int n = lane;
                const float v = ((IMP[(0 * 64 + qq) * 64 + n] + IMP[(1 * 64 + qq) * 64 + n]) + IMP[(2 * 64 + qq) * 64 + n]) + IMP[(3 * 64 + qq) * 64 + n];
                unsigned key = (__float_as_uint(fmaxf(v, 0.f)) & ~63u) | (unsigned)(63 - n);
                if (n == 0 || n == i || n == i - 1) key = 0xFFFFFFFFu;
                if (n > i) key = 0u;
                unsigned thr = 0u;
                for (int bit = 31; bit >= 0; --bit) { const unsigned cand = thr | (1u << bit);
                    const int cnt = __builtin_popcountll(__builtin_amdgcn_ballot_w64(key >= cand)); if (cnt >= 16) thr = cand; }
                const unsigned long long sm = __builtin_amdgcn_ballot_w64(key >= thr) & validm;
                if (lane == 0) SEL[qq] = sm;
            }
            __syncthreads();
            mysel = SEL[ql];
            unsigned long long u = SEL[lane];
            unsigned ulo = (unsigned)u, uhi = (unsigned)(u >> 32);
#pragma unroll
            for (int o = 1; o < 64; o <<= 1) { ulo |= __shfl_xor(ulo, o); uhi |= __shfl_xor(uhi, o); }
            um = ((unsigned long long)uhi << 32) | ulo;
        } else { mysel = validm; um = validm; }
    }
    bf16x8 qr[4];
    { const float* ct = (const float*)(c.ws + O_TAB) + (size_t)t * 32; const float* stb = ct + 4096 * 32;
#pragma unroll
      for (int s = 0; s < 2; ++s) {
          const f32x4 c0 = *(const f32x4*)(ct + 16 * s + 8 * hi), c1 = *(const f32x4*)(ct + 16 * s + 8 * hi + 4);
          const f32x4 s0 = *(const f32x4*)(stb + 16 * s + 8 * hi), s1 = *(const f32x4*)(stb + 16 * s + 8 * hi + 4);
          float lo_[8], hi_[8], ol[8], oh[8];
#pragma unroll
          for (int j = 0; j < 8; ++j) { lo_[j] = bf2f((bf16)qn[s][j]); hi_[j] = bf2f((bf16)qn[s + 2][j]); }
#pragma unroll
          for (int j = 0; j < 8; ++j) { const float cc = j < 4 ? c0[j & 3] : c1[j & 3], ss = j < 4 ? s0[j & 3] : s1[j & 3];
              ol[j] = lo_[j] * cc - hi_[j] * ss; oh[j] = hi_[j] * cc + lo_[j] * ss; }
          qr[s] = pack8(ol[0], ol[1], ol[2], ol[3], ol[4], ol[5], ol[6], ol[7]); qr[s + 2] = pack8(oh[0], oh[1], oh[2], oh[3], oh[4], oh[5], oh[6], oh[7]); } }
#ifndef SKN_SLC
    {
        const bf16* Kg = (const bf16*)(c.ws + O_KS) + ((size_t)g * T + (size_t)b * SEQ) * 64;
        const bf16* Vg = (const bf16*)(c.ws + O_VS) + ((size_t)g * T + (size_t)b * SEQ) * 64;
        ASt st; st.m = NEGB; st.l = 0.f; st.o0 = f32x16{}; st.o1 = f32x16{};
        unsigned long long rem = um;
        int n = __builtin_ctzll(rem); rem &= rem - 1ull;
        TileRegs tr = tile_fetch(Kg, Vg, 64 * n, tid);
        int k = 0;
        for (;;) {
            tile_stage(tr, lds, k & 1, tid);
            __syncthreads();
            const bool more = rem != 0ull; int nn = 0;
            if (more) { nn = __builtin_ctzll(rem); rem &= rem - 1ull; tr = tile_fetch(Kg, Vg, 64 * nn, tid); }
            const bool selb = (mysel >> n) & 1ull;
            const int lo = selb ? 0 : 64; const int hv = (n == i) ? ql : 63;
            tile_compute<false>(lds, k & 1, qr, lo, hv, st, dum0, dum1, 0, wsf, lane);
            ++k; if (!more) break; n = nn;
        }
        branch_fold(st, g_s2, false, wsf, lane);
#pragma unroll
        for (int rg = 0; rg < 16; ++rg) { OACC[rg * 64] = st.o0[rg]; OACC[(16 + rg) * 64] = st.o1[rg]; }
        __syncthreads();
    }
#endif
#ifndef SKN_WIN
    {
        const bf16* Kg = (const bf16*)(c.ws + O_KW) + ((size_t)g * T + (size_t)b * SEQ) * 64;
        const bf16* Vg = (const bf16*)(c.ws + O_VW) + ((size_t)g * T + (size_t)b * SEQ) * 64;
        ASt st; st.m = NEGB; st.l = 0.f; st.o0 = f32x16{}; st.o1 = f32x16{};
        const int nlast = i - 8 < 0 ? 0 : i - 8;
        TileRegs tr = tile_fetch(Kg, Vg, 64 * i, tid);
        int k = 0;
        for (int n = i; n >= nlast; --n, ++k) {
            tile_stage(tr, lds, k & 1, tid);
            __syncthreads();
            if (n - 1 >= nlast) tr = tile_fetch(Kg, Vg, 64 * (n - 1), tid);
            int lo = 0, hv = 63;
            if (n == i) hv = ql;
            if (n == i - 8) lo = ql + 1;
            tile_compute<false>(lds, k & 1, qr, lo, hv, st, dum0, dum1, 0, wsf, lane);
        }
        branch_fold(st, g_w2, false, wsf, lane);
#pragma unroll
        for (int rg = 0; rg < 16; ++rg) { const unsigned w = OC[rg * 64]; ca0[rg] = (OACC[rg * 64] + st.o0[rg]) + bflo(w); ca1[rg] = (OACC[(16 + rg) * 64] + st.o1[rg]) + bfhi(w); }
        __syncthreads();
    }
#endif
    { const size_t g0 = ((size_t)b * SEQ + i * 64 + 32 * qh) * 512 + head * 64;
      const bf16* nzg = (const bf16*)(c.ws + O_NZ) + g0; bf16* ong = (bf16*)(c.ws + O_ONSA) + g0;
      LAS unsigned char* S = lds + A_OC + wid * 4096;
#pragma unroll
      for (int it = 0; it < 4; ++it) { const int rw = 8 * it + (lane >> 3), ch = lane & 7;
          *(LAS u32x4*)(S + rw * 128 + ch * 16) = *(const u32x4*)(nzg + (size_t)rw * 512 + ch * 8); }
      LDS_WAIT();
#pragma unroll
      for (int rg = 0; rg < 16; ++rg) { LAS bf16* e = (LAS bf16*)(S + ((rg & 3) + 8 * (rg >> 2) + 4 * hi) * 128 + r * 2);
          const float z0 = bf2f(e[0]), z1 = bf2f(e[32]);
          e[0] = (bf16)(cvtpk(ca0[rg] * siluf_(z0), 0.f) & 0xffffu);
          e[32] = (bf16)(cvtpk(ca1[rg] * siluf_(z1), 0.f) & 0xffffu); }
      LDS_WAIT();
#pragma unroll
      for (int it = 0; it < 4; ++it) { const int rw = 8 * it + (lane >> 3), ch = lane & 7;
          *(u32x4*)(ong + (size_t)rw * 512 + ch * 8) = *(const LAS u32x4*)(S + rw * 128 + ch * 16); }
      LDS_WAIT(); }
}
DI void cmp_stage2(const Ctx& c0, int layer) {
    const Ctx c = launder(c0);
    const float* cp = (const float*)(c.ws + O_CPART); const float* cb = (const float*)(c.ws + O_CBIAS) + layer * 256;
    bf16* out = (bf16*)(c.ws + O_KCMP);
    for (int task = (c.tid < 256) ? (int)blockIdx.x * 256 + c.tid : 4 * 2048 * 8; task < 4 * 2048 * 8; task += c.G * 256) {
        const int oct = task & 7, row = (task >> 3) & 2047, which = task >> 14, kv = which >> 1;
        const float* w2 = c.a->in[kv ? I_CW2V : I_CW2K] + (size_t)layer * 128 * 64 + 8 * oct;
        const float* p0 = cp + ((size_t)which * 2048 + row) * 128;
        float acc[8] = {0.f, 0.f, 0.f, 0.f, 0.f, 0.f, 0.f, 0.f};
        for (int h4 = 0; h4 < 128; h4 += 4) {
            f32x4 s = *(const f32x4*)(p0 + h4);
#pragma unroll
            for (int ks = 1; ks < 4; ++ks) s += *(const f32x4*)(p0 + (size_t)ks * 4 * 2048 * 128 + h4);
            s += *(const f32x4*)(cb + kv * 128 + h4);
#pragma unroll
            for (int j = 0; j < 4; ++j) { const float hv = siluf_(s[j]); const f32x4 w0 = *(const f32x4*)(w2 + (size_t)(h4 + j) * 64), w1 = *(const f32x4*)(w2 + (size_t)(h4 + j) * 64 + 4);
                acc[0] += hv * w0[0]; acc[1] += hv * w0[1]; acc[2] += hv * w0[2]; acc[3] += hv * w0[3]; acc[4] += hv * w1[0]; acc[5] += hv * w1[1]; acc[6] += hv * w1[2]; acc[7] += hv * w1[3]; }
        }
        u32x4 w; w.x = cvtpk(acc[0], acc[1]); w.y = cvtpk(acc[2], acc[3]); w.z = cvtpk(acc[4], acc[5]); w.w = cvtpk(acc[6], acc[7]);
        *(u32x4*)(out + ((size_t)which * 2048 + row) * 64 + 8 * oct) = w;
    }
}
DI void post_phase(const Ctx& c0, int layer) {
    const Ctx c = launder(c0);
    const bf16* ob = (const bf16*)(c.ws + O_OUTB); const float* xin = layer == 0 ? c.a->in[I_X] : c.out;
    const float* gp = c.a->in[I_GPOST] + (size_t)layer * DM; const float* gn = c.a->in[I_GPRE] + (size_t)(layer + 1 < 2 ? layer + 1 : 1) * DM;
    const int gw = blockIdx.x * 8 + c.wid, NGW = c.G * 8, lane = c.lane;
    for (int m = gw; m < T; m += NGW) {
        float o[16]; float ss = 0.f;
#pragma unroll
        for (int j = 0; j < 2; ++j) { const u32x4 w = *(const u32x4*)(ob + (size_t)m * DM + 512 * j + 8 * lane);
            o[8 * j + 0] = bflo(w.x); o[8 * j + 1] = bfhi(w.x); o[8 * j + 2] = bflo(w.y); o[8 * j + 3] = bfhi(w.y); o[8 * j + 4] = bflo(w.z); o[8 * j + 5] = bfhi(w.z); o[8 * j + 6] = bflo(w.w); o[8 * j + 7] = bfhi(w.w); }
#pragma unroll
        for (int e = 0; e < 16; ++e) ss += o[e] * o[e];
        const float rr = 1.f / sqrtf(wave_sum(ss) * (1.f / 1024.f) + EPS);
        float xn[16]; float s2 = 0.f;
#pragma unroll
        for (int j = 0; j < 2; ++j)
#pragma unroll
            for (int q = 0; q < 2; ++q) { const size_t off = (size_t)m * DM + 512 * j + 8 * lane + 4 * q; const f32x4 xv = *(const f32x4*)(xin + off); const f32x4 g = *(const f32x4*)(gp + 512 * j + 8 * lane + 4 * q);
                f32x4 y;
#pragma unroll
                for (int k = 0; k < 4; ++k) { y[k] = xv[k] + o[8 * j + 4 * q + k] * rr * g[k]; xn[8 * j + 4 * q + k] = y[k]; s2 += y[k] * y[k]; }
                *(f32x4*)(c.out + off) = y; }
        if (layer == 0) {
            const float r2 = 1.f / sqrtf(wave_sum(s2) * (1.f / 1024.f) + EPS);
            bf16* hb = (bf16*)(c.ws + O_HB) + (size_t)m * DM;
#pragma unroll
            for (int j = 0; j < 2; ++j) { const f32x4 g0 = *(const f32x4*)(gn + 512 * j + 8 * lane), g1 = *(const f32x4*)(gn + 512 * j + 8 * lane + 4);
                u32x4 w; w.x = cvtpk(xn[8 * j] * r2 * g0[0], xn[8 * j + 1] * r2 * g0[1]); w.y = cvtpk(xn[8 * j + 2] * r2 * g0[2], xn[8 * j + 3] * r2 * g0[3]);
                w.z = cvtpk(xn[8 * j + 4] * r2 * g1[0], xn[8 * j + 5] * r2 * g1[1]); w.w = cvtpk(xn[8 * j + 6] * r2 * g1[2], xn[8 * j + 7] * r2 * g1[3]);
                *(u32x4*)(hb + 512 * j + 8 * lane) = w; }
        }
    }
}

constexpr size_t O_BAR = O_CBIAS + 65536;
DI Ctx make_ctx(const Args& a) {
    Ctx cb; cb.a = &a; cb.out = a.out; cb.ws = a.ws; cb.tid = threadIdx.x; cb.lane = cb.tid & 63; cb.wid = __builtin_amdgcn_readfirstlane(cb.tid >> 6); cb.G = gridDim.x;
    { const int bx = blockIdx.x; cb.vcu = (cb.G % 8 == 0) ? (bx % 8) * (cb.G / 8) + bx / 8 : bx; }
    return cb;
}
template <int PH> DI void run_phase(const Ctx& cb, LAS unsigned char* lds, int layer) {
    if constexpr (PH == 0) { phase0(cb, lds); }
    if constexpr (PH == 1) { const Ctx c = launder(cb); pg8::Gemm g{(const pg8::bf16_t*)(c.ws + O_HB), (const pg8::bf16_t*)(c.ws + O_WIN + (size_t)layer * 11 * MiB), T, NPHYS, 1024, 1024, 1024};
        pg8::StaticOrder S; S.init(T, NPHYS, c.G, (int)blockIdx.x); EpiProj E{c.ws};
        pg8::gemm_phase<EpiProj, pg8::StaticOrder, true, true>(lds, g, S, E); }
    if constexpr (PH == 2) {
        { const Ctx c = launder(cb);
          for (int cu = blockIdx.x; cu < 128; cu += c.G) { const int which = cu >> 5, ks = (cu >> 3) & 3, pm = cu & 7, kv = which >> 1;
            pg8::Gemm g{(const pg8::bf16_t*)(c.ws + O_KCRAW) + (size_t)which * KCR_ROWS * 64 + ks * 512,
                        (const pg8::bf16_t*)(c.ws + O_WC1 + (size_t)(layer * 2 + kv) * MiB) + ks * 512, 2048, 256, 512, 1024, 2048};
            OneUnit S{pm, true}; EpiCPart E{(float*)(c.ws + O_CPART) + ((size_t)(ks * 4 + which) * 2048) * 128};
            pg8::gemm_phase<EpiCPart, OneUnit, false, true>(lds, g, S, E); } }
        __syncthreads();
        {
          const int bx = blockIdx.x; const bool bal = cb.G == 256;
          const int nun = bal ? (bx < 128 ? 7 : 9) : (2048 - bx + cb.G - 1) / cb.G;
          for (int k = 0; k < nun; ++k) { const int u = bal ? (k < 7 ? bx + 256 * k : 1792 + 2 * (bx - 128) + (k - 7)) : bx + cb.G * k; gla_stage1(cb, layer, u, lds); } }
    }
    if constexpr (PH == 3) { cmp_stage2(cb, layer); { const Ctx c = launder(cb); gla_stage2(c); } }
    if constexpr (PH == 4) {
        for (int sl = cb.vcu; sl < 256; sl += cb.G) { const int bg = sl >> 4, s = sl & 15;
#pragma unroll 1
            for (int it = 0; it < 4; ++it) { const int i = (it == 0) ? s : (it == 1) ? 31 - s : (it == 2) ? 32 + s : 63 - s; nsa_unit(cb, bg >> 1, bg & 1, i, lds); } }
        __syncthreads();
        for (int pu = blockIdx.x * 4 + (cb.wid >> 1); pu < 2048; pu += cb.G * 4) gla_stage3(cb, layer, pu, cb.wid & 1, lds);
#ifdef PROBE_G3X2
        __syncthreads();
        for (int pu = blockIdx.x * 4 + (cb.wid >> 1); pu < 2048; pu += cb.G * 4) gla_stage3(cb, layer, pu, cb.wid & 1, lds);
#endif
    }
    if constexpr (PH == 5) {
        { const Ctx c = launder(cb); pg8::Gemm g{(const pg8::bf16_t*)(c.ws + O_ONSA), (const pg8::bf16_t*)(c.ws + O_WUPN + (size_t)layer * MiB), T, 1024, 512, 512, 512};
          pg8::StaticOrder S; S.init(T, 1024, c.G, (int)blockIdx.x); EpiUp<false> E{(const bf16*)(c.ws + O_MG), (bf16*)(c.ws + O_Y)};
          pg8::gemm_phase<EpiUp<false>, pg8::StaticOrder, true, true>(lds, g, S, E); }
        __syncthreads();
        { const Ctx c = launder(cb); pg8::Gemm g{(const pg8::bf16_t*)(c.ws + O_OGLA), (const pg8::bf16_t*)(c.ws + O_WUPG + (size_t)layer * MiB), T, 1024, 512, 512, 512};
          pg8::StaticOrder S; S.init(T, 1024, c.G, (int)blockIdx.x); EpiUp<true> E{(const bf16*)(c.ws + O_MG) + 1024, (bf16*)(c.ws + O_Y)};
          pg8::gemm_phase<EpiUp<true>, pg8::StaticOrder, true, true>(lds, g, S, E); }
    }
    if constexpr (PH == 6) { const Ctx c = launder(cb); pg8::Gemm g{(const pg8::bf16_t*)(c.ws + O_Y), (const pg8::bf16_t*)(c.ws + O_WOUT + (size_t)layer * 2 * MiB), T, 1024, 1024, 1024, 1024};
        pg8::StaticOrder S; S.init(T, 1024, c.G, (int)blockIdx.x); EpiPlain E{(bf16*)(c.ws + O_OUTB), 1024};
        pg8::gemm_phase<EpiPlain, pg8::StaticOrder, true, true>(lds, g, S, E); }
    if constexpr (PH == 7) { post_phase(cb, layer); }
}
#ifndef ONE_LAUNCH
#define ONE_LAUNCH 1
#endif
#ifndef PLAN
#define PLAN 0
#endif
#if ONE_LAUNCH
template <int L> DI void run_layer(const Ctx& cb, LAS unsigned char* lds, const XcdBarrier& xbar, bool last) {
    run_phase<1>(cb, lds, L); xcd_barrier(xbar);
    run_phase<2>(cb, lds, L); xcd_barrier(xbar);
    run_phase<3>(cb, lds, L); xcd_barrier(xbar);
    run_phase<4>(cb, lds, L); xcd_barrier(xbar);
    run_phase<5>(cb, lds, L); xcd_barrier(xbar);
    run_phase<6>(cb, lds, L); xcd_barrier(xbar);
    run_phase<7>(cb, lds, L); if (!last) xcd_barrier(xbar);
}
__global__ void __launch_bounds__(512, 2) nsa_gla_fwd(Args a) {
    extern __shared__ __attribute__((aligned(16))) unsigned char lds_raw[];
    LAS unsigned char* lds = (LAS unsigned char*)lds_raw;
    cg::grid_group grid = cg::this_grid();
    const Ctx cb = make_ctx(a);
    volatile LAS unsigned* bst = (volatile LAS unsigned*)(lds + LDS_BYTES - 64);
    if (threadIdx.x == 0) { bst[0] = 0u; bst[1] = 0u; }
    __syncthreads();
    const XcdBarrier xbar = xcd_barrier_post((unsigned*)(a.ws + O_BAR), bst);
    run_phase<0>(cb, lds, 0);
    xcd_barrier(xbar);
    run_layer<0>(cb, lds, xbar, false);
    run_layer<1>(cb, lds, xbar, true);
    if (gridDim.x > 100000u) grid.sync();
}
#else
template <int PH> __global__ void __launch_bounds__(512, 2) k_phase(Args a, int layer) {
    extern __shared__ __attribute__((aligned(16))) unsigned char lds_raw[];
    LAS unsigned char* lds = (LAS unsigned char*)lds_raw;
    const Ctx cb = make_ctx(a);
    run_phase<PH>(cb, lds, layer);
}
template <int LO, int HI> __global__ void __launch_bounds__(512, 2) k_range(Args a, int layer, int region) {
    extern __shared__ __attribute__((aligned(16))) unsigned char lds_raw[];
    LAS unsigned char* lds = (LAS unsigned char*)lds_raw;
    cg::grid_group grid = cg::this_grid();
    const Ctx cb = make_ctx(a);
    volatile LAS unsigned* bst = (volatile LAS unsigned*)(lds + LDS_BYTES - 64);
    if (threadIdx.x == 0) { bst[0] = 0u; bst[1] = 0u; }
    __syncthreads();
    const XcdBarrier xbar = xcd_barrier_post((unsigned*)(a.ws + O_BAR) + 4096 * region, bst);
    if constexpr (LO <= 1 && 1 <= HI) { run_phase<1>(cb, lds, layer); if constexpr (1 < HI) xcd_barrier(xbar); }
    if constexpr (LO <= 2 && 2 <= HI) { run_phase<2>(cb, lds, layer); if constexpr (2 < HI) xcd_barrier(xbar); }
    if constexpr (LO <= 3 && 3 <= HI) { run_phase<3>(cb, lds, layer); if constexpr (3 < HI) xcd_barrier(xbar); }
    if constexpr (LO <= 4 && 4 <= HI) { run_phase<4>(cb, lds, layer); if constexpr (4 < HI) xcd_barrier(xbar); }
    if constexpr (LO <= 5 && 5 <= HI) { run_phase<5>(cb, lds, layer); if constexpr (5 < HI) xcd_barrier(xbar); }
    if constexpr (LO <= 6 && 6 <= HI) { run_phase<6>(cb, lds, layer); if constexpr (6 < HI) xcd_barrier(xbar); }
    if constexpr (LO <= 7 && 7 <= HI) { run_phase<7>(cb, lds, layer); }
    if (layer > 1000) grid.sync();
}
template <int LO, int HI> static void launch_range(const Args& a, int layer, int region, hipStream_t stream) {
    static bool attr = false;
    if (!attr) { (void)hipFuncSetAttribute((const void*)k_range<LO, HI>, hipFuncAttributeMaxDynamicSharedMemorySize, LDS_BYTES); attr = true; }
    Args aa = a; int ll = layer, rr = region; void* args[] = {&aa, &ll, &rr};
    hipError_t e = hipLaunchCooperativeKernel((const void*)k_range<LO, HI>, dim3(256), dim3(512), args, LDS_BYTES, stream);
    if (e != hipSuccess) fprintf(stderr, "k_range<%d,%d> cooperative launch failed: %s\n", LO, HI, hipGetErrorString(e));
}
template <int PH> static void launch_phase(const Args& a, int layer, hipStream_t stream) {
    static bool attr = false;
    if (!attr) { (void)hipFuncSetAttribute((const void*)k_phase<PH>, hipFuncAttributeMaxDynamicSharedMemorySize, LDS_BYTES); attr = true; }
    hipLaunchKernelGGL(k_phase<PH>, dim3(256), dim3(512), LDS_BYTES, stream, a, layer);
}
#endif

extern "C" void kernel_launch(void* const* d_in, const int* in_sizes, int n_in, void* d_out, int out_size, void* d_ws, size_t ws_size, hipStream_t stream) {
    if (n_in != 16 || ws_size < WS_END) { fprintf(stderr, "kernel_launch: need 16 inputs and %zu bytes of workspace (got %d, %zu)\n", (size_t)WS_END, n_in, ws_size); return; }
    Args a{};
    for (int i = 0; i < 16; ++i) a.in[i] = (const float*)d_in[i];
    a.out = (float*)d_out; a.ws = (unsigned char*)d_ws;
#if ONE_LAUNCH
    static int grid = 0;
    if (grid == 0) {
        int dev = 0, cus = 0, per_cu = 0;
        (void)hipGetDevice(&dev); (void)hipDeviceGetAttribute(&cus, hipDeviceAttributeMultiprocessorCount, dev);
        if (hipFuncSetAttribute((const void*)nsa_gla_fwd, hipFuncAttributeMaxDynamicSharedMemorySize, LDS_BYTES) != hipSuccess) { fprintf(stderr, "kernel_launch: hipFuncSetAttribute failed\n"); grid = -1; return; }
        if (hipOccupancyMaxActiveBlocksPerMultiprocessor(&per_cu, (const void*)nsa_gla_fwd, 512, LDS_BYTES) != hipSuccess || per_cu < 1) { fprintf(stderr, "kernel_launch: occupancy query gave %d\n", per_cu); per_cu = 1; }
        (void)hipGetLastError();
        grid = cus * per_cu; if (grid > 256) grid = 256;
    }
    if (grid < 0) return;
    if (hipMemsetAsync((char*)d_ws + O_BAR, 0, 16384, stream) != hipSuccess) { fprintf(stderr, "kernel_launch: memset failed\n"); return; }
    void* args[] = {&a};
    hipError_t e = hipLaunchCooperativeKernel((const void*)nsa_gla_fwd, dim3(grid), dim3(512), args, LDS_BYTES, stream);
    if (e != hipSuccess) fprintf(stderr, "cooperative launch failed: %s (grid %d)\n", hipGetErrorString(e), grid);
#else
    if (hipMemsetAsync((char*)d_ws + O_BAR, 0, 16 * 16384, stream) != hipSuccess) { fprintf(stderr, "kernel_launch: memset failed\n"); return; }
    launch_phase<0>(a, 0, stream);
    for (int layer = 0; layer < 2; ++layer) {
#if PLAN == 1
        launch_phase<1>(a, layer, stream); launch_range<2, 3>(a, layer, layer * 4 + 0, stream); launch_phase<4>(a, layer, stream); launch_range<5, 7>(a, layer, layer * 4 + 1, stream);
#elif PLAN == 2
        launch_range<1, 3>(a, layer, layer * 4 + 0, stream); launch_phase<4>(a, layer, stream); launch_range<5, 7>(a, layer, layer * 4 + 1, stream);
#elif PLAN == 3
        launch_range<1, 3>(a, layer, layer * 4 + 0, stream); launch_range<4, 7>(a, layer, layer * 4 + 1, stream);
#elif PLAN == 4
        launch_range<1, 7>(a, layer, layer * 4 + 0, stream);
#else
        launch_phase<1>(a, layer, stream); launch_phase<2>(a, layer, stream); launch_phase<3>(a, layer, stream); launch_phase<4>(a, layer, stream);
        launch_phase<5>(a, layer, stream); launch_phase<6>(a, layer, stream); launch_phase<7>(a, layer, stream);
#endif
    }
#endif
}
```

```cpp
#include <hip/hip_runtime.h>
#include <hip/hip_cooperative_groups.h>
#include <cstdio>
#include <cstdint>
#include <cmath>
namespace cg = cooperative_groups;
namespace pg8 {
#define PG8_LAS __attribute__((address_space(3)))
typedef unsigned short bf16_t;
typedef short bf16x8 __attribute__((ext_vector_type(8)));
typedef float f32x4 __attribute__((ext_vector_type(4)));
typedef unsigned u32x4 __attribute__((ext_vector_type(4)));
constexpr int BM = 256, BK = 64, HALF = 128, HTB = HALF * BK * 2  , STAGE_BYTES = 8 * HTB, NXCD = 8, WGM = 8;

__host__ __device__ __forceinline__ int lds_byte(int r, int c) { const int st = (r >> 4) * 2 + (c >> 5), rr = r & 15, cc = c & 31, ob = rr * 64 + cc * 2; return st * 1024 + (ob ^ (((ob >> 9) & 1) << 5)); }
__host__ __device__ __forceinline__ void stage_rc(int b, int& R, int& C) { const int st = b / 1024, sb = b % 1024, swz = sb ^ (((sb >> 9) & 1) << 5); R = (st >> 1) * 16 + swz / 64; C = (st & 1) * 32 + (swz % 64) / 2; }
__host__ __device__ __forceinline__ int perm32(int rho) { const int n = rho >> 4, i = rho & 15; return 8 * (i >> 2) + 4 * n + (i & 3); }

struct Unit { int pm, pn; };
struct Gemm { const bf16_t* A; const bf16_t* Bt; int M, N, K, lda, ldb; };

struct StaticOrder {
    int nM, nN, nwg, G, c;
    __host__ __device__ void init(int M, int N, int G_, int c_) { nM = M / BM; nN = N / BM; nwg = nM * nN; G = G_; c = c_; }
    __host__ __device__ bool next(int i, Unit& u) const {
        const long L = (long)i * G + c; if (L >= nwg) return false;
        int wgid = (int)L; { const int q = nwg / NXCD, r = nwg % NXCD, xcd = wgid % NXCD, off = wgid / NXCD; wgid = (xcd < r ? xcd * (q + 1) : r * (q + 1) + (xcd - r) * q) + off; }
        const int nig = WGM * nN, gid = wgid / nig, fm = gid * WGM, gsz = (nM - fm) < WGM ? (nM - fm) : WGM;
        u.pm = fm + ((wgid % nig) % gsz); u.pn = (wgid % nig) / gsz; return true;
    }
    __device__ __forceinline__ void a_ready(const Unit&) const {}
    __device__ __forceinline__ void done(const Unit&) const {}
};

__device__ __forceinline__ unsigned cvt_pk_bf16(float lo, float hi) { unsigned r; asm volatile("v_cvt_pk_bf16_f32 %0, %1, %2" : "=v"(r) : "v"(lo), "v"(hi)); return r; }
typedef float f32x2 __attribute__((ext_vector_type(2)));
template <class Epi, class Sched, bool ALIGN_EPI = false, bool SP2 = false>
__device__ __forceinline__ void gemm_phase(PG8_LAS unsigned char* lds, const Gemm g, const Sched& S, const Epi& E) {
    int tid_ = threadIdx.x; asm volatile("" : "+v"(tid_)); const int tid = tid_, wid = __builtin_amdgcn_readfirstlane(tid >> 6), lane = tid & 63, wr = wid >> 2, wc = wid & 3, fr = lane & 15, fq = lane >> 4;
    const int K = g.K, nt = K / BK;
    unsigned voffA[2], voffB[2];
#pragma unroll
    for (int i = 0; i < 2; ++i) { int R, C; stage_rc(tid * 16 + i * 8192, R, C); const int Rb = Epi::PERM ? ((R & ~31) + perm32(R & 31)) : R;
        voffA[i] = (unsigned)(R * g.lda + C) * 2u; voffB[i] = (unsigned)(Rb * g.ldb + C) * 2u; }
    const size_t kstep = (size_t)(BK * 2);
    const size_t hstepA = (size_t)HALF * g.lda * 2, hstepB = (size_t)HALF * g.ldb * 2;
    const size_t tstepA = 2 * hstepA, tstepB = 2 * hstepB;
    const unsigned ldsw = (unsigned)wid * 1024u;
    const int aoff = lds_byte(wr * 64 + fr, fq * 8), boff = lds_byte(wc * 32 + fr, fq * 8);
#define PG8_SA(b, h) (((b) * 2 + (h)) * HTB)
#define PG8_SB(b, h) ((4 + (b) * 2 + (h)) * HTB)
#define PG8_STAGE(bufoff, gbase, voff) do { _Pragma("unroll") for (int _i = 0; _i < 2; ++_i) \
        __builtin_amdgcn_global_load_lds((const unsigned*)((const char*)(gbase) + (voff)[_i]), (PG8_LAS unsigned*)(lds + (bufoff) + ldsw + _i * 8192), 16, 0, 0); } while (0)
#define PG8_LDA(dst, b, h) do { _Pragma("unroll") for (int m = 0; m < 4; ++m) _Pragma("unroll") for (int k = 0; k < 2; ++k) dst[m][k] = *(const PG8_LAS bf16x8*)(lds + PG8_SA(b, h) + aoff + m * 2048 + k * 1024); } while (0)
#define PG8_LDB(dst, b, h) do { _Pragma("unroll") for (int n = 0; n < 2; ++n) _Pragma("unroll") for (int k = 0; k < 2; ++k) dst[n][k] = *(const PG8_LAS bf16x8*)(lds + PG8_SB(b, h) + boff + n * 2048 + k * 1024); } while (0)
#define PG8_MMA(ai, bj, At, Bt) do { __builtin_amdgcn_s_setprio(1); _Pragma("unroll") for (int m = 0; m < 4; ++m) _Pragma("unroll") for (int n = 0; n < 2; ++n) _Pragma("unroll") for (int k = 0; k < 2; ++k) \
        acc[ai][bj][m][n] = __builtin_amdgcn_mfma_f32_16x16x32_bf16(Bt[n][k], At[m][k], acc[ai][bj][m][n], 0, 0, 0); __builtin_amdgcn_s_setprio(0); } while (0)
#define PG8_WAIT_V(n) asm volatile("s_waitcnt vmcnt(" #n ")" ::: "memory")
#define PG8_WAIT_L(n) asm volatile("s_waitcnt lgkmcnt(" #n ")" ::: "memory")
#define PG8_BAR __builtin_amdgcn_s_barrier()
#define PG8_SCHED __builtin_amdgcn_sched_barrier(0)
    Unit cur, nxt; int ui = 0;
    if (!S.next(0, cur)) return;
    f32x4 acc[2][2][4][2];
#pragma unroll
    for (int a = 0; a < 2; ++a)
#pragma unroll
        for (int b = 0; b < 2; ++b)
#pragma unroll
            for (int m = 0; m < 4; ++m)
#pragma unroll
                for (int n = 0; n < 2; ++n) acc[a][b][m][n] = (f32x4){0.f, 0.f, 0.f, 0.f};
    bf16x8 At[4][2], B0[2][2], B1[2][2];
    const char* cA = (const char*)g.A + (size_t)cur.pm * tstepA; const char* cB = (const char*)g.Bt + (size_t)cur.pn * tstepB;
    S.a_ready(cur);
    if constexpr (SP2) {
        PG8_STAGE(PG8_SB(0, 0), cB, voffB); PG8_STAGE(PG8_SB(0, 1), cB + hstepB, voffB); PG8_STAGE(PG8_SA(0, 0), cA, voffA); PG8_STAGE(PG8_SA(0, 1), cA + hstepA, voffA);
        if (wr == 1) PG8_BAR;
        PG8_WAIT_V(2); PG8_BAR;
        PG8_STAGE(PG8_SB(1, 0), cB + kstep, voffB); PG8_STAGE(PG8_SA(1, 0), cA + kstep, voffA); PG8_STAGE(PG8_SB(1, 1), cB + hstepB + kstep, voffB);
        PG8_WAIT_V(6); PG8_BAR;
    } else {
        PG8_STAGE(PG8_SB(0, 0), cB, voffB); PG8_STAGE(PG8_SA(0, 0), cA, voffA); PG8_STAGE(PG8_SB(0, 1), cB + hstepB, voffB); PG8_STAGE(PG8_SA(0, 1), cA + hstepA, voffA);
        if (wr == 1) PG8_BAR;
        PG8_WAIT_V(4); PG8_BAR;
        PG8_STAGE(PG8_SB(1, 0), cB + kstep, voffB); PG8_STAGE(PG8_SA(1, 0), cA + kstep, voffA); PG8_STAGE(PG8_SB(1, 1), cB + hstepB + kstep, voffB);
        PG8_WAIT_V(6); PG8_BAR;
    }
    for (;;) {
        const bool has_next = S.next(ui + 1, nxt);
        const char* nA = has_next ? (const char*)g.A + (size_t)nxt.pm * tstepA : cA; const char* nB = has_next ? (const char*)g.Bt + (size_t)nxt.pn * tstepB : cB;
        for (int t = 0; t < nt; t += 2) {
            const bool last = (t == nt - 2);
            const char* a1 = cA + (size_t)(t + 1) * kstep;
            const char* a2 = last ? nA : cA + (size_t)(t + 2) * kstep; const char* b2 = last ? nB : cB + (size_t)(t + 2) * kstep;
            const char* a3 = a2 + kstep; const char* b3 = b2 + kstep;
            if (last && has_next) S.a_ready(nxt);
            if constexpr (SP2) {
            PG8_LDB(B0, 0, 0); PG8_LDB(B1, 0, 1); PG8_SCHED; PG8_LDA(At, 0, 0); PG8_STAGE(PG8_SA(1, 1), a1 + hstepA, voffA);
            PG8_WAIT_V(8); PG8_WAIT_L(0); PG8_BAR; PG8_MMA(0, 0, At, B0); PG8_MMA(0, 1, At, B1); PG8_BAR; PG8_SCHED;
            PG8_LDA(At, 0, 1); PG8_STAGE(PG8_SB(0, 0), b2, voffB); PG8_STAGE(PG8_SB(0, 1), b2 + hstepB, voffB); PG8_STAGE(PG8_SA(0, 0), a2, voffA);
            PG8_WAIT_V(8); PG8_WAIT_L(0); PG8_BAR; PG8_MMA(1, 0, At, B0); PG8_MMA(1, 1, At, B1); PG8_BAR; PG8_SCHED;
            PG8_LDB(B0, 1, 0); PG8_LDB(B1, 1, 1); PG8_SCHED; PG8_LDA(At, 1, 0); PG8_STAGE(PG8_SA(0, 1), a2 + hstepA, voffA);
            PG8_WAIT_V(8); PG8_WAIT_L(0); PG8_BAR; PG8_MMA(0, 0, At, B0); PG8_MMA(0, 1, At, B1); PG8_BAR; PG8_SCHED;
            PG8_LDA(At, 1, 1); PG8_STAGE(PG8_SB(1, 0), b3, voffB); PG8_STAGE(PG8_SB(1, 1), b3 + hstepB, voffB); PG8_STAGE(PG8_SA(1, 0), a3, voffA);
            PG8_WAIT_V(8); PG8_WAIT_L(0); PG8_BAR; PG8_MMA(1, 0, At, B0); PG8_MMA(1, 1, At, B1); PG8_BAR; PG8_SCHED;
            } else {
            PG8_LDB(B0, 0, 0); PG8_SCHED; PG8_LDA(At, 0, 0); PG8_STAGE(PG8_SA(1, 1), a1 + hstepA, voffA);
            PG8_WAIT_L(8); PG8_BAR; PG8_WAIT_L(0); PG8_MMA(0, 0, At, B0); PG8_BAR; PG8_SCHED;
            PG8_LDB(B1, 0, 1); PG8_STAGE(PG8_SB(0, 0), b2, voffB);
            PG8_BAR; PG8_WAIT_L(0); PG8_MMA(0, 1, At, B1); PG8_BAR;
            PG8_LDA(At, 0, 1); PG8_STAGE(PG8_SA(0, 0), a2, voffA);
            PG8_BAR; PG8_WAIT_L(0); PG8_MMA(1, 0, At, B0); PG8_BAR; PG8_SCHED;
            PG8_STAGE(PG8_SB(0, 1), b2 + hstepB, voffB);
            PG8_WAIT_V(6); PG8_BAR; PG8_MMA(1, 1, At, B1); PG8_BAR;
            PG8_LDB(B0, 1, 0); PG8_SCHED; PG8_LDA(At, 1, 0); PG8_STAGE(PG8_SA(0, 1), a2 + hstepA, voffA);
            PG8_WAIT_L(8); PG8_BAR; PG8_WAIT_L(0); PG8_MMA(0, 0, At, B0); PG8_BAR; PG8_SCHED;
            PG8_LDB(B1, 1, 1); PG8_STAGE(PG8_SB(1, 0), b3, voffB);
            PG8_BAR; PG8_WAIT_L(0); PG8_MMA(0, 1, At, B1); PG8_BAR;
            PG8_LDA(At, 1, 1); PG8_STAGE(PG8_SA(1, 0), a3, voffA);
            PG8_BAR; PG8_WAIT_L(0); PG8_MMA(1, 0, At, B0); PG8_BAR; PG8_SCHED;
            PG8_STAGE(PG8_SB(1, 1), b3 + hstepB, voffB);
            PG8_WAIT_V(6); PG8_BAR; PG8_MMA(1, 1, At, B1); PG8_BAR;
            }
        }
        if constexpr (ALIGN_EPI) { if (wr == 0) PG8_BAR; }
        if constexpr (!Epi::AFTER_DRAIN) { E(acc, cur, wr, wc, fr, fq); S.done(cur); }
        if (!has_next) break;
#pragma unroll
        for (int a = 0; a < 2; ++a)
#pragma unroll
            for (int b = 0; b < 2; ++b)
#pragma unroll
                for (int m = 0; m < 4; ++m)
#pragma unroll
                    for (int n = 0; n < 2; ++n) acc[a][b][m][n] = (f32x4){0.f, 0.f, 0.f, 0.f};
        cur = nxt; cA = nA; cB = nB; ++ui;
        if constexpr (ALIGN_EPI) { if (wr == 1) PG8_BAR; }
    }
    PG8_WAIT_V(0);
    if constexpr (!ALIGN_EPI) { if (wr == 0) PG8_BAR; }
    PG8_BAR;
    if constexpr (Epi::AFTER_DRAIN) { E.fused(acc, cur, wr, wc, fr, fq, lds, wid, lane); S.done(cur); }
#undef PG8_SA
#undef PG8_SB
#undef PG8_STAGE
#undef PG8_LDA
#undef PG8_LDB
#undef PG8_MMA
#undef PG8_WAIT_V
#undef PG8_WAIT_L
#undef PG8_BAR
#undef PG8_SCHED
}
}
#define LAS __attribute__((address_space(3)))
#define DI __device__ __forceinline__
typedef unsigned short bf16;
typedef short bf16x8 __attribute__((ext_vector_type(8)));
typedef short s16x4 __attribute__((ext_vector_type(4)));
typedef float f32x4 __attribute__((ext_vector_type(4)));
typedef float f32x2 __attribute__((ext_vector_type(2)));
typedef float f32x16 __attribute__((ext_vector_type(16)));
typedef unsigned u32x4 __attribute__((ext_vector_type(4)));
typedef unsigned u32x2 __attribute__((ext_vector_type(2)));
typedef __bf16 bf16x2_t __attribute__((ext_vector_type(2)));
typedef short v4i16_t __attribute__((ext_vector_type(4)));

constexpr int NB = 8, SEQ = 4096, T = NB * SEQ, DM = 1024, NPHYS = 5632, DIN = 5416;
constexpr float C2 = 0.125f * 1.4426950408889634f;
constexpr float EPS = 1e-6f;
constexpr float NEGB = -1e30f;
constexpr size_t MiB = 1u << 20;
constexpr size_t O_WIN = 0, O_WUPN = 22 * MiB, O_WUPG = 24 * MiB, O_WOUT = 26 * MiB, O_WC1 = 30 * MiB, O_TAB = 34 * MiB, O_CBIAS = 35 * MiB,
    O_HB = 36 * MiB, O_QN = 100 * MiB, O_KS = 132 * MiB, O_KW = 140 * MiB, O_VS = 148 * MiB, O_VW = 156 * MiB, O_KCRAW = 164 * MiB, O_NZ = 181 * MiB,
    O_GQ = 213 * MiB, O_GK = 229 * MiB, O_GV = 245 * MiB, O_GR = 277 * MiB, O_MG = 309 * MiB, O_MISC = 437 * MiB, O_KCMP = 441 * MiB, O_UPD = 442 * MiB,
    O_DECAY = 506 * MiB, WS_END = 507 * MiB;
constexpr size_t O_Y = O_HB, O_OINTRA = O_HB, O_QG = O_HB + 32 * MiB, O_CPART = O_HB + 48 * MiB;
constexpr size_t O_ONSA = O_GQ, O_OGLA = O_GV, O_OUTB = O_GQ;
constexpr int KCR_ROWS = T + 64;
constexpr int LDS_BYTES = 139264;

#define LDS_WAIT() asm volatile("s_waitcnt lgkmcnt(0)" ::: "memory")
DI unsigned cvtpk(float lo, float hi) { f32x2 v = {lo, hi}; bf16x2_t b = __builtin_convertvector(v, bf16x2_t); return __builtin_bit_cast(unsigned, b); }
DI float bflo(unsigned w) { return __uint_as_float(w << 16); }
DI float bfhi(unsigned w) { return __uint_as_float(w & 0xffff0000u); }
DI float bf2f(bf16 b) { return __uint_as_float(((unsigned)b) << 16); }
DI float sigmoidf_(float x) { return 1.f / (1.f + __expf(-x)); }
DI float siluf_(float x) { return x / (1.f + __expf(-x)); }
DI float wave_sum(float v) {
#pragma unroll
    for (int o = 1; o < 64; o <<= 1) v += __shfl_xor(v, o);
    return v;
}
DI int crow(int reg, int hi) { return (reg & 3) + 8 * (reg >> 2) + 4 * hi; }
#define MFMA32(a, b, c) __builtin_amdgcn_mfma_f32_32x32x16_bf16((a), (b), (c), 0, 0, 0)
DI s16x4 vtr(const LAS unsigned char* p) { return __builtin_bit_cast(s16x4, __builtin_amdgcn_ds_read_tr16_b64_v4i16((LAS v4i16_t*)p)); }
DI bf16x8 cat8(s16x4 lo, s16x4 hi) { return __builtin_shufflevector(lo, hi, 0, 1, 2, 3, 4, 5, 6, 7); }
DI bf16x8 pack8(float a0, float a1, float a2, float a3, float a4, float a5, float a6, float a7) {
    u32x4 w; w.x = cvtpk(a0, a1); w.y = cvtpk(a2, a3); w.z = cvtpk(a4, a5); w.w = cvtpk(a6, a7); return __builtin_bit_cast(bf16x8, w);
}

struct Args { const float* in[16]; float* out; unsigned char* ws; };
struct Ctx {
    const Args* a;
    float* out;
    unsigned char* ws;
    int tid, lane, wid, G, vcu;
};
DI Ctx launder(const Ctx& c0) { Ctx c = c0; asm volatile("" : "+s"(c.ws), "+s"(c.out), "+v"(c.tid)); return c; }
enum { I_X = 0, I_GPRE, I_WIN, I_CPK, I_CW1K, I_CW2K, I_CPV, I_CW1V, I_CW2V, I_GWA, I_GBA, I_GNORM, I_WUPN, I_WUPG, I_WOUT, I_GPOST };

DI void map_block(int pb, int& src0, int& nvalid) {
    const int tile = pb >> 3, blk = pb & 7; nvalid = 32;
    if (tile <= 1) src0 = tile * 256 + blk * 32;
    else if (tile == 2) { const int bj = blk >> 2, hh = blk & 3; src0 = (hh < 2 ? 768 + hh * 64 : 1024 + (hh - 2) * 64) + 32 * bj; }
    else if (tile == 3) src0 = blk < 4 ? 512 + 32 * blk : 640 + 32 * (blk - 4);
    else if (tile == 4) src0 = blk < 4 ? 896 + 32 * blk : 1152 + 32 * (blk - 4);
    else if (tile <= 6) src0 = 1304 + (tile - 5) * 256 + 32 * blk;
    else if (tile == 7) src0 = 1816 + 32 * blk;
    else if (tile == 8) src0 = 2072 + 32 * blk;
    else if (tile <= 10) src0 = 2328 + (tile - 9) * 256 + 32 * blk;
    else if (tile <= 12) src0 = 2856 + (tile - 11) * 256 + 32 * blk;
    else if (tile <= 20) src0 = 3368 + (tile - 13) * 256 + 32 * blk;
    else { if (blk == 0) { src0 = 1280; nvalid = 24; } else if (blk == 1) { src0 = 2840; nvalid = 16; } else { src0 = 0; nvalid = 0; } }
}
DI void transpose_item(const float* W, int ldw, int src0, int nvalid, int ldk, bf16* WT, int dst_row0, LAS float* scr, int kb, int lane) {
    const int k0 = 64 * kb, n = lane & 31;
    float tv[32];
#pragma unroll
    for (int i = 0; i < 32; ++i) { const int kk = 2 * i + (lane >> 5); tv[i] = 0.f; if (n < nvalid) tv[i] = W[(size_t)(k0 + kk) * ldw + src0 + n]; }
#pragma unroll
    for (int i = 0; i < 32; ++i) { const int kk = 2 * i + (lane >> 5); scr[kk * 33 + n] = tv[i]; }
    LDS_WAIT();
    const int c = lane & 7;
#pragma unroll
    for (int j = 0; j < 4; ++j) { const int nn = (lane >> 3) + 8 * j; const LAS float* s = scr + (8 * c) * 33 + nn;
        u32x4 o; o.x = cvtpk(s[0 * 33], s[1 * 33]); o.y = cvtpk(s[2 * 33], s[3 * 33]); o.z = cvtpk(s[4 * 33], s[5 * 33]); o.w = cvtpk(s[6 * 33], s[7 * 33]);
        *(u32x4*)(WT + (size_t)(dst_row0 + nn) * ldk + k0 + 8 * c) = o; }
    LDS_WAIT();
}
DI void rms_row_bf16(const float* xrow, const float* g, bf16* orow, int lane) {
    f32x4 v[4]; float s = 0.f;
#pragma unroll
    for (int j = 0; j < 4; ++j) { v[j] = ((const f32x4*)xrow)[lane + 64 * j]; s += (v[j].x * v[j].x + v[j].y * v[j].y) + (v[j].z * v[j].z + v[j].w * v[j].w); }
    const float r = 1.f / sqrtf(wave_sum(s) * (1.f / 1024.f) + EPS);
#pragma unroll
    for (int j = 0; j < 4; ++j) { const f32x4 gg = ((const f32x4*)g)[lane + 64 * j]; u32x2 o; o.x = cvtpk(v[j].x * r * gg.x, v[j].y * r * gg.y); o.y = cvtpk(v[j].z * r * gg.z, v[j].w * r * gg.w);
        ((u32x2*)orow)[lane + 64 * j] = o; }
}
DI void phase0(const Ctx& c0, LAS unsigned char* lds) {
    const Ctx c = launder(c0);
    LAS float* scr = (LAS float*)(lds + c.wid * 16384);
    const int gw = blockIdx.x * 8 + c.wid, NGW = c.G * 8;
    constexpr int PER_L = 2816 + 256 + 256 + 512 + 256 + 256;
    for (int it = gw; it < 2 * PER_L; it += NGW) {
        const int l = it / PER_L; int r = it % PER_L;
        if (r < 2816) { const int pb = r >> 4, kb = r & 15; int src0, nv; map_block(pb, src0, nv);
            transpose_item(c.a->in[I_WIN] + (size_t)l * 1024 * DIN, DIN, src0, nv, 1024, (bf16*)(c.ws + O_WIN + (size_t)l * 11 * MiB), pb * 32, scr, kb, c.lane); continue; }
        r -= 2816;
        if (r < 256) { transpose_item(c.a->in[I_WUPN] + (size_t)l * 512 * 1024, 1024, (r & 31) * 32, 32, 512, (bf16*)(c.ws + O_WUPN + (size_t)l * MiB), (r & 31) * 32, scr, r >> 5, c.lane); continue; }
        r -= 256;
        if (r < 256) { transpose_item(c.a->in[I_WUPG] + (size_t)l * 512 * 1024, 1024, (r & 31) * 32, 32, 512, (bf16*)(c.ws + O_WUPG + (size_t)l * MiB), (r & 31) * 32, scr, r >> 5, c.lane); continue; }
        r -= 256;
        if (r < 512) { transpose_item(c.a->in[I_WOUT] + (size_t)l * 1024 * 1024, 1024, (r & 31) * 32, 32, 1024, (bf16*)(c.ws + O_WOUT + (size_t)l * 2 * MiB), (r & 31) * 32, scr, r >> 5, c.lane); continue; }
        r -= 512;
        { const int kv = r >> 8; r &= 255; const int nb = r & 7, kb = r >> 3;
          transpose_item(c.a->in[kv ? I_CW1V : I_CW1K] + (size_t)l * 2048 * 128, 128, (nb & 3) * 32, nb < 4 ? 32 : 0, 2048, (bf16*)(c.ws + O_WC1 + (size_t)(l * 2 + kv) * MiB), nb * 32, scr, kb, c.lane); }
    }
    { float* ct = (float*)(c.ws + O_TAB); float* st = ct + 4096 * 32;
      for (int i = blockIdx.x * 512 + c.tid; i < 4096 * 32; i += c.G * 512) { const int pos = i >> 5, e = i & 31;
          const float inv = (float)pow(10000.0, -(double)e / 32.0); const float ang = (float)pos * inv;
          const double a = (double)ang; const double k = rint(a * 0.15915494309189535); const double rr = a - k * 6.283185307179586;
          ct[i] = cosf((float)rr); st[i] = sinf((float)rr); } }
    { float* cb = (float*)(c.ws + O_CBIAS);
      for (int o = gw; o < 512; o += NGW) { const int l = o >> 8, kv = (o >> 7) & 1, h = o & 127;
          const float* pos = c.a->in[kv ? I_CPV : I_CPK] + (size_t)l * 2048; const float* w1 = c.a->in[kv ? I_CW1V : I_CW1K] + (size_t)l * 2048 * 128;
          float s = 0.f;
          for (int i = 0; i < 32; ++i) { const int ld = c.lane + 64 * i; s += pos[ld] * w1[(size_t)ld * 128 + h]; }
          s = wave_sum(s); if (c.lane == 0) cb[o] = s; } }
    for (int m = gw; m < T; m += NGW) rms_row_bf16(c.a->in[I_X] + (size_t)m * DM, c.a->in[I_GPRE], (bf16*)(c.ws + O_HB) + (size_t)m * DM, c.lane);
}

struct EpiProj {
    static constexpr bool PERM = true, AFTER_DRAIN = false;
    unsigned char* ws;
    DI void operator()(const pg8::f32x4 (&acc)[2][2][4][2], const pg8::Unit& u, int wr, int wc, int fr, int fq) const {
        const int pn = u.pn; const int row0 = u.pm * 256 + wr * 64 + fr;
        if (pn == 2) {
            const float* ct = (const float*)(ws + O_TAB); const float* st = ct + 4096 * 32;
            bf16* dst = (bf16*)(ws + O_KS) + (size_t)wc * T * 64;
#pragma unroll
            for (int ai = 0; ai < 2; ++ai)
#pragma unroll
                for (int m = 0; m < 4; ++m) { const int row = row0 + ai * 128 + m * 16; const int pos = row & (SEQ - 1);
                    const f32x4 c0 = *(const f32x4*)(ct + pos * 32 + 8 * fq), c1 = *(const f32x4*)(ct + pos * 32 + 8 * fq + 4);
                    const f32x4 s0 = *(const f32x4*)(st + pos * 32 + 8 * fq), s1 = *(const f32x4*)(st + pos * 32 + 8 * fq + 4);
                    const f32x4 l0 = acc[ai][0][m][0], l1 = acc[ai][0][m][1], h0 = acc[ai][1][m][0], h1 = acc[ai][1][m][1];
                    const f32x4 ol0 = l0 * c0 - h0 * s0, ol1 = l1 * c1 - h1 * s1, oh0 = h0 * c0 + l0 * s0, oh1 = h1 * c1 + l1 * s1;
                    u32x4 w; w.x = cvtpk(ol0[0], ol0[1]); w.y = cvtpk(ol0[2], ol0[3]); w.z = cvtpk(ol1[0], ol1[1]); w.w = cvtpk(ol1[2], ol1[3]);
                    *(u32x4*)(dst + (size_t)row * 64 + 8 * fq) = w;
                    w.x = cvtpk(oh0[0], oh0[1]); w.y = cvtpk(oh0[2], oh0[3]); w.z = cvtpk(oh1[0], oh1[1]); w.w = cvtpk(oh1[2], oh1[3]);
                    *(u32x4*)(dst + (size_t)row * 64 + 32 + 8 * fq) = w; }
            return;
        }
        bf16* base; int ld; size_t gs = 64; float sc = 1.f;
        if (pn <= 1) { base = (bf16*)(ws + O_QN) + pn * 256; ld = 512; sc = C2; }
        else if (pn == 3) { base = (bf16*)(ws + O_KCRAW); ld = 64; gs = (size_t)KCR_ROWS * 64; }
        else if (pn == 4) { base = (bf16*)(ws + O_VS); ld = 64; gs = (size_t)T * 64; }
        else if (pn <= 6) { base = (bf16*)(ws + O_NZ) + (pn - 5) * 256; ld = 512; }
        else if (pn == 7) { base = (bf16*)(ws + O_GQ); ld = 256; }
        else if (pn == 8) { base = (bf16*)(ws + O_GK); ld = 256; }
        else if (pn <= 10) { base = (bf16*)(ws + O_GV) + (pn - 9) * 256; ld = 512; }
        else if (pn <= 12) { base = (bf16*)(ws + O_GR) + (pn - 11) * 256; ld = 512; }
        else if (pn <= 20) { base = (bf16*)(ws + O_MG) + (pn - 13) * 256; ld = 2048; }
        else { base = (bf16*)(ws + O_MISC); ld = 64; }
#pragma unroll
        for (int bj = 0; bj < 2; ++bj) {
            const int col = 128 * bj + 32 * wc + 8 * fq; const int grp = col >> 6, cin = col & 63;
            if (pn == 21 && grp > 0) continue;
            bf16* bp = base + (size_t)grp * gs + cin;
#pragma unroll
            for (int ai = 0; ai < 2; ++ai)
#pragma unroll
                for (int m = 0; m < 4; ++m) { const int row = row0 + ai * 128 + m * 16;
                    const f32x4 v0 = acc[ai][bj][m][0] * sc, v1 = acc[ai][bj][m][1] * sc;
                    u32x4 w; w.x = cvtpk(v0[0], v0[1]); w.y = cvtpk(v0[2], v0[3]); w.z = cvtpk(v1[0], v1[1]); w.w = cvtpk(v1[2], v1[3]);
                    *(u32x4*)(bp + (size_t)row * ld) = w; }
        }
    }
};
struct EpiCPart {
    static constexpr bool PERM = false, AFTER_DRAIN = false;
    float* dst;
    DI void operator()(const pg8::f32x4 (&acc)[2][2][4][2], const pg8::Unit& u, int wr, int wc, int fr, int fq) const {
        const int row0 = u.pm * 256 + wr * 64 + fr;
#pragma unroll
        for (int ai = 0; ai < 2; ++ai)
#pragma unroll
            for (int m = 0; m < 4; ++m) { const int row = row0 + ai * 128 + m * 16;
#pragma unroll
                for (int n = 0; n < 2; ++n) *(f32x4*)(dst + (size_t)row * 128 + 32 * wc + 16 * n + 4 * fq) = acc[ai][0][m][n]; }
    }
};
template <bool ADD> struct EpiUp {
    static constexpr bool PERM = true, AFTER_DRAIN = false;
    const bf16* mg; bf16* y;
    DI void operator()(const pg8::f32x4 (&acc)[2][2][4][2], const pg8::Unit& u, int wr, int wc, int fr, int fq) const {
        const int row0 = u.pm * 256 + wr * 64 + fr;
#pragma unroll
        for (int bj = 0; bj < 2; ++bj) { const int col = u.pn * 256 + 128 * bj + 32 * wc + 8 * fq;
#pragma unroll
            for (int ai = 0; ai < 2; ++ai)
#pragma unroll
                for (int m = 0; m < 4; ++m) { const int row = row0 + ai * 128 + m * 16;
                    const u32x4 g = *(const u32x4*)(mg + (size_t)row * 2048 + col);
                    const f32x4 a0 = acc[ai][bj][m][0], a1 = acc[ai][bj][m][1];
                    float v[8];
                    v[0] = sigmoidf_(bflo(g.x)) * a0[0]; v[1] = sigmoidf_(bfhi(g.x)) * a0[1]; v[2] = sigmoidf_(bflo(g.y)) * a0[2]; v[3] = sigmoidf_(bfhi(g.y)) * a0[3];
                    v[4] = sigmoidf_(bflo(g.z)) * a1[0]; v[5] = sigmoidf_(bfhi(g.z)) * a1[1]; v[6] = sigmoidf_(bflo(g.w)) * a1[2]; v[7] = sigmoidf_(bfhi(g.w)) * a1[3];
                    u32x4* yp = (u32x4*)(y + (size_t)row * 1024 + col);
                    if (ADD) { const u32x4 o = *yp; v[0] += bflo(o.x); v[1] += bfhi(o.x); v[2] += bflo(o.y); v[3] += bfhi(o.y); v[4] += bflo(o.z); v[5] += bfhi(o.z); v[6] += bflo(o.w); v[7] += bfhi(o.w); }
                    u32x4 w; w.x = cvtpk(v[0], v[1]); w.y = cvtpk(v[2], v[3]); w.z = cvtpk(v[4], v[5]); w.w = cvtpk(v[6], v[7]);
                    *yp = w; }
        }
    }
};
struct EpiPlain {
    static constexpr bool PERM = true, AFTER_DRAIN = false;
    bf16* O; int ldc;
    DI void operator()(const pg8::f32x4 (&acc)[2][2][4][2], const pg8::Unit& u, int wr, int wc, int fr, int fq) const {
        const int row0 = u.pm * 256 + wr * 64 + fr;
#pragma unroll
        for (int bj = 0; bj < 2; ++bj) { const int col = u.pn * 256 + 128 * bj + 32 * wc + 8 * fq;
#pragma unroll
            for (int ai = 0; ai < 2; ++ai)
#pragma unroll
                for (int m = 0; m < 4; ++m) { const int row = row0 + ai * 128 + m * 16;
                    const f32x4 v0 = acc[ai][bj][m][0], v1 = acc[ai][bj][m][1];
                    u32x4 w; w.x = cvtpk(v0[0], v0[1]); w.y = cvtpk(v0[2], v0[3]); w.z = cvtpk(v1[0], v1[1]); w.w = cvtpk(v1[2], v1[3]);
                    *(u32x4*)(O + (size_t)row * ldc + col) = w; }
        }
    }
};
struct OneUnit {
    int pm; bool has;
    DI bool next(int i, pg8::Unit& u) const { if (i > 0 || !has) return false; u.pm = pm; u.pn = 0; return true; }
    DI void a_ready(const pg8::Unit&) const {}
    DI void done(const pg8::Unit&) const {}
};
#define XB_TMO      128
#define XB_XCNT(j)  (256  + 64 * (j))
#define XB_XSUB(j)  (1280 + 64 * (j))
#define XB_XGEN(j)  (2304 + 64 * (j))
#define XB_TOP      3328
#define XB_TOPGEN   3392
#define XCD_BAR_WORDS 3456
#define XB_SPIN_CAP (1u << 18)

__device__ __forceinline__ unsigned xb_ld(unsigned* p)              { return __hip_atomic_load(p, __ATOMIC_RELAXED, __HIP_MEMORY_SCOPE_AGENT); }
__device__ __forceinline__ unsigned xb_add(unsigned* p, unsigned v) { return __hip_atomic_fetch_add(p, v, __ATOMIC_RELAXED, __HIP_MEMORY_SCOPE_AGENT); }
__device__ __forceinline__ unsigned xb_xcc_id() { return (unsigned)__builtin_amdgcn_s_getreg((3 << 11) | 20) & 0xFu; }
#define XB_SPIN(cond, bar) do { unsigned _sp = 0; while (cond) { __builtin_amdgcn_s_sleep(1); \
    if ((++_sp & 255u) == 0u) { if (xb_ld(&(bar)[XB_TMO])) break; if (_sp > XB_SPIN_CAP) { atomicAdd(&(bar)[XB_TMO], 1u); break; } } } } while (0)

struct XcdBarrier {
    unsigned* bar; unsigned x;
    volatile LAS unsigned* st;
};

__device__ __forceinline__ XcdBarrier xcd_barrier_post(unsigned* bar, volatile LAS unsigned* st) {
    XcdBarrier b; b.bar = bar; b.x = xb_xcc_id(); b.st = st;
    if (threadIdx.x == 0) (void)xb_add(&bar[XB_XCNT(b.x)], 1u);
    return b;
}
__device__ __forceinline__ void xcd_barrier_complete(unsigned* bar, unsigned x, unsigned& nloc, unsigned& nx) {
    const unsigned G = gridDim.x * gridDim.y * gridDim.z;
    unsigned sum, cnt, mine, sp = 0u;
    for (;;) {
        sum = 0u; cnt = 0u; mine = 0u;
#pragma unroll
        for (unsigned j = 0; j < 16; ++j) { const unsigned c = xb_ld(&bar[XB_XCNT(j)]); sum += c; cnt += (c > 0u) ? 1u : 0u; mine = (j == x) ? c : mine; }
        if (sum == G) break;
        __builtin_amdgcn_s_sleep(1);
        if ((++sp & 255u) == 0u) { if (xb_ld(&bar[XB_TMO])) break; if (sp > XB_SPIN_CAP) { atomicAdd(&bar[XB_TMO], 1u); break; } }
    }
    nloc = mine > 0u ? mine : 1u; nx = cnt > 0u ? cnt : 1u;
}

__device__ __forceinline__ void xcd_barrier(const XcdBarrier& b) {
    asm volatile("s_waitcnt vmcnt(0)" ::: "memory");
    __syncthreads();
    if (threadIdx.x == 0) {
        unsigned* bar = b.bar;
        __builtin_amdgcn_s_waitcnt(0);
        unsigned nloc = b.st[0], nx = b.st[1];
        if (nloc == 0u) { xcd_barrier_complete(bar, b.x, nloc, nx); b.st[0] = nloc; b.st[1] = nx; }
        const unsigned old = xb_add(&bar[XB_XSUB(b.x)], 1u);
        const unsigned gen = old / nloc;
        if (old + 1u == (gen + 1u) * nloc) {
            __builtin_amdgcn_fence(__ATOMIC_RELEASE, "agent");
            asm volatile("s_waitcnt vmcnt(0)" ::: "memory");
            const unsigned og = xb_add(&bar[XB_TOP], 1u);
            const unsigned tg = og / nx;
            if (og + 1u == (tg + 1u) * nx) xb_add(&bar[XB_TOPGEN], 1u);
            else XB_SPIN(xb_ld(&bar[XB_TOPGEN]) == tg, bar);
            __builtin_amdgcn_fence(__ATOMIC_ACQUIRE, "agent");
            xb_add(&bar[XB_XGEN(b.x)], 1u);
            asm volatile("s_waitcnt vmcnt(0)" ::: "memory");
        } else {
            XB_SPIN(xb_ld(&bar[XB_XGEN(b.x)]) == gen, bar);
            __builtin_amdgcn_fence(__ATOMIC_ACQUIRE, "agent");
            asm volatile("s_waitcnt vmcnt(0)" ::: "memory");
        }
    }
    __syncthreads();
}
constexpr int G1_LA = 0, G1_PART = 16640, G1_QGT = 18688, G1_KGT = G1_QGT + 8192, G1_KU = G1_KGT + 8192, G1_VI = G1_KU + 8192, G1_END = G1_VI + 16384;
DI void gla_stage1(const Ctx& c0, int layer, int unit, LAS unsigned char* lds) {
    const Ctx c = launder(c0);
    const int tid = c.tid, lane = c.lane, wid = c.wid, r = lane & 31, hi = lane >> 5;
    const int bh = unit >> 6, n = unit & 63, b = bh >> 2, h = bh & 3;
    const size_t row0 = (size_t)b * SEQ + n * 64;
    LAS float* LA = (LAS float*)(lds + G1_LA); LAS float* PART = (LAS float*)(lds + G1_PART);
    const bf16* gq = (const bf16*)(c.ws + O_GQ); const bf16* gk = (const bf16*)(c.ws + O_GK); const bf16* gv = (const bf16*)(c.ws + O_GV);
    const bf16* misc = (const bf16*)(c.ws + O_MISC);
    const float* Wa = c.a->in[I_GWA] + (size_t)layer * 16 * 256 + h * 64; const float* ba = c.a->in[I_GBA] + (size_t)layer * 256 + h * 64;
    const int cc = tid >> 3, ch = tid & 7;
#pragma unroll
    for (int it = 0; it < 2; ++it) { const int idx = tid + 512 * it, vc_ = idx & 15, c_ = idx >> 4;
        const u32x4 v = *(const u32x4*)(gv + (row0 + c_) * 512 + h * 128 + vc_ * 8);
        *(LAS u32x4*)(lds + G1_VI + (vc_ >> 2) * 4096 + c_ * 64 + (vc_ & 3) * 16) = v; }
    {
        float ga[16];
        { const u32x4 g0 = *(const u32x4*)(misc + (row0 + cc) * 64 + 32), g1 = *(const u32x4*)(misc + (row0 + cc) * 64 + 40);
          ga[0] = bflo(g0.x); ga[1] = bfhi(g0.x); ga[2] = bflo(g0.y); ga[3] = bfhi(g0.y); ga[4] = bflo(g0.z); ga[5] = bfhi(g0.z); ga[6] = bflo(g0.w); ga[7] = bfhi(g0.w);
          ga[8] = bflo(g1.x); ga[9] = bfhi(g1.x); ga[10] = bflo(g1.y); ga[11] = bfhi(g1.y); ga[12] = bflo(g1.z); ga[13] = bfhi(g1.z); ga[14] = bflo(g1.w); ga[15] = bfhi(g1.w); }
        f32x4 a0 = *(const f32x4*)(ba + 8 * ch), a1 = *(const f32x4*)(ba + 8 * ch + 4);
        const float* wap = Wa + 8 * ch; asm volatile("" : "+v"(wap));
#pragma unroll
        for (int rr = 0; rr < 16; ++rr) { const f32x4 w0 = *(const f32x4*)(wap + rr * 256), w1 = *(const f32x4*)(wap + rr * 256 + 4); a0 += w0 * ga[rr]; a1 += w1 * ga[rr]; }
#pragma unroll
        for (int j = 0; j < 8; ++j) { const float x = j < 4 ? a0[j & 3] : a1[j & 3];
            const float ls = fminf(x, 0.f) - __logf(1.f + __expf(-fabsf(x)));
            LA[cc * 65 + 8 * ch + j] = ls * (1.f / 16.f); }
    }
    __syncthreads();
    {
        const int d = tid & 63, part = tid >> 6; float v[8]; float run = 0.f;
#pragma unroll
        for (int j = 0; j < 8; ++j) { run += LA[(8 * part + j) * 65 + d]; v[j] = run; }
        PART[part * 64 + d] = run;
        __syncthreads();
        float off = 0.f;
#pragma unroll
        for (int p = 0; p < 8; ++p) off += (p < part) ? PART[p * 64 + d] : 0.f;
#pragma unroll
        for (int j = 0; j < 8; ++j) LA[(8 * part + j) * 65 + d] = v[j] + off;
    }
    __syncthreads();
    {
        const u32x4 qw = *(const u32x4*)(gq + (row0 + cc) * 256 + h * 64 + 8 * ch), kw = *(const u32x4*)(gk + (row0 + cc) * 256 + h * 64 + 8 * ch);
        float q[8], k[8];
        q[0] = bflo(qw.x); q[1] = bfhi(qw.x); q[2] = bflo(qw.y); q[3] = bfhi(qw.y); q[4] = bflo(qw.z); q[5] = bfhi(qw.z); q[6] = bflo(qw.w); q[7] = bfhi(qw.w);
        k[0] = bflo(kw.x); k[1] = bfhi(kw.x); k[2] = bflo(kw.y); k[3] = bfhi(kw.y); k[4] = bflo(kw.z); k[5] = bfhi(kw.z); k[6] = bflo(kw.w); k[7] = bfhi(kw.w);
        float qg[8], kg[8], ku[8];
#pragma unroll
        for (int j = 0; j < 8; ++j) { const float bb = LA[cc * 65 + 8 * ch + j], bl = LA[63 * 65 + 8 * ch + j];
            const float en = __expf(-bb); qg[j] = q[j] * 0.125f * __expf(bb); kg[j] = k[j] * en; ku[j] = k[j] * __expf(bl - bb); }
        const bf16x8 qv = pack8(qg[0], qg[1], qg[2], qg[3], qg[4], qg[5], qg[6], qg[7]);
        *(LAS bf16x8*)(lds + G1_QGT + ch * 1024 + cc * 16) = qv;
        *(bf16x8*)((bf16*)(c.ws + O_QG) + (row0 + cc) * 256 + h * 64 + 8 * ch) = qv;
        *(LAS bf16x8*)(lds + G1_KGT + ch * 1024 + cc * 16) = pack8(kg[0], kg[1], kg[2], kg[3], kg[4], kg[5], kg[6], kg[7]);
        *(LAS bf16x8*)(lds + G1_KU + (ch >> 2) * 4096 + cc * 64 + (ch & 3) * 16) = pack8(ku[0], ku[1], ku[2], ku[3], ku[4], ku[5], ku[6], ku[7]);
        if (tid < 64) ((float*)(c.ws + O_DECAY))[(size_t)unit * 64 + tid] = __expf(LA[63 * 65 + tid]);
    }
    __syncthreads();
    {
        const int cb = wid & 1, vb = wid >> 1;
        const LAS unsigned char* kb = lds + G1_KGT + hi * 1024 + r * 16;
        const LAS unsigned char* qb = lds + G1_QGT + hi * 1024 + (r + 32 * cb) * 16;
        bf16x8 qf[4];
#pragma unroll
        for (int s = 0; s < 4; ++s) qf[s] = *(const LAS bf16x8*)(qb + s * 2048);
        const int cl = 32 * cb + r;
        bf16x8 pa[4];
#pragma unroll
        for (int jb = 0; jb < 2; ++jb) {
            f32x16 x = {};
            if (jb <= cb) {
#pragma unroll
                for (int s = 0; s < 4; ++s) { const bf16x8 a = *(const LAS bf16x8*)(kb + s * 2048 + jb * 512); x = MFMA32(a, qf[s], x); }
#pragma unroll
                for (int rg = 0; rg < 16; ++rg) { const int j = 32 * jb + crow(rg, hi); if (j > cl) x[rg] = 0.f; }
            }
            pa[2 * jb] = pack8(x[0], x[1], x[2], x[3], x[4], x[5], x[6], x[7]);
            pa[2 * jb + 1] = pack8(x[8], x[9], x[10], x[11], x[12], x[13], x[14], x[15]);
        }
        const int troff = (4 * hi + ((lane & 15) >> 2)) * 64 + ((lane >> 4) & 1) * 32 + (lane & 3) * 8;
        const LAS unsigned char* vbp = lds + G1_VI + vb * 4096 + troff;
        const LAS unsigned char* kup = lds + G1_KU + cb * 4096 + troff;
        f32x16 o = {}, uacc = {};
#pragma unroll
        for (int s = 0; s < 4; ++s) {
            const bf16x8 vf = cat8(vtr(vbp + s * 1024), vtr(vbp + s * 1024 + 512));
            const bf16x8 kf = cat8(vtr(kup + s * 1024), vtr(kup + s * 1024 + 512));
            o = MFMA32(pa[s], vf, o);
            uacc = MFMA32(kf, vf, uacc);
        }
        LAS unsigned char* S1 = lds + 65536 + wid * 2048;
        float* upp = (float*)(c.ws + O_UPD) + (size_t)unit * 8192 + (32 * cb + 4 * hi) * 128 + 32 * vb + r; asm volatile("" : "+v"(upp));
#pragma unroll
        for (int rg = 0; rg < 16; ++rg) { const int ro = (rg & 3) + 8 * (rg >> 2);
            *(LAS bf16*)(S1 + (ro + 4 * hi) * 64 + r * 2) = (bf16)(cvtpk(o[rg], 0.f) & 0xffffu);
            upp[ro * 128] = uacc[rg]; }
        LDS_WAIT();
        { bf16* oib = (bf16*)(c.ws + O_OINTRA) + (row0 + 32 * cb) * 512 + h * 128 + 32 * vb;
#pragma unroll
          for (int it = 0; it < 2; ++it) { const int cidx = lane + 64 * it, rw = cidx >> 2, chn = cidx & 3;
              *(u32x4*)(oib + (size_t)rw * 512 + chn * 8) = *(const LAS u32x4*)(S1 + rw * 64 + chn * 16); } }
        LDS_WAIT();
    }
    __syncthreads();
}
DI void gla_stage2(const Ctx& c) {
    float* upd = (float*)(c.ws + O_UPD); const float* dec = (const float*)(c.ws + O_DECAY);
    for (int e = blockIdx.x * 512 + c.tid; e < 32 * 4096; e += c.G * 512) {
        const int bh = e >> 12, pp = e & 4095, d = pp >> 6, v2 = (pp & 63) * 2;
        float* p = upd + (size_t)bh * 64 * 8192 + d * 128 + v2; const float* dp = dec + (size_t)bh * 64 * 64 + d;
        float s0 = 0.f, s1 = 0.f;
        for (int n0 = 0; n0 < 64; n0 += 16) {
            f32x2 u[16]; float dd[16];
#pragma unroll
            for (int j = 0; j < 16; ++j) { u[j] = *(const f32x2*)(p + (size_t)(n0 + j) * 8192); dd[j] = dp[(n0 + j) * 64]; }
#pragma unroll
            for (int j = 0; j < 16; ++j) { *(f32x2*)(p + (size_t)(n0 + j) * 8192) = (f32x2){s0, s1}; s0 = dd[j] * s0 + u[j].x; s1 = dd[j] * s1 + u[j].y; }
        }
    }
}
constexpr int G3_PITCH = 272, G3_BYTES = 32 * G3_PITCH;
DI void g3_tile_in(const bf16* g, LAS unsigned char* R, int lane) {
#pragma unroll
    for (int it = 0; it < 8; ++it) { const int row = 4 * it + (lane >> 4), ch = lane & 15;
        *(LAS u32x4*)(R + row * G3_PITCH + ch * 16) = *(const u32x4*)(g + (size_t)row * 512 + ch * 8); }
    LDS_WAIT();
}
DI void g3_tile_out(bf16* g, const LAS unsigned char* R, int lane) {
    LDS_WAIT();
#pragma unroll
    for (int it = 0; it < 8; ++it) { const int row = 4 * it + (lane >> 4), ch = lane & 15;
        *(u32x4*)(g + (size_t)row * 512 + ch * 8) = *(const LAS u32x4*)(R + row * G3_PITCH + ch * 16); }
    LDS_WAIT();
}
DI void gla_stage3(const Ctx& c0, int layer, int unit, int cb, LAS unsigned char* lds) {
    const Ctx c = launder(c0);
    const int lane = c.lane, r = lane & 31, hi = lane >> 5;
    const int bh = unit >> 6, n = unit & 63, b = bh >> 2, h = bh & 3;
    const size_t row0 = (size_t)b * SEQ + n * 64 + 32 * cb;
    LAS unsigned char* R = lds + c.wid * G3_BYTES;
    const LAS unsigned char* Re = R + (4 * hi) * G3_PITCH + r * 2;
    const bf16* qgp = (const bf16*)(c.ws + O_QG) + (row0 + r) * 256 + h * 64 + 8 * hi;
    const float* sp = (const float*)(c.ws + O_UPD) + (size_t)unit * 8192;
    const float* gn = c.a->in[I_GNORM] + (size_t)layer * 128;
    bf16x8 qf[4];
#pragma unroll
    for (int s = 0; s < 4; ++s) qf[s] = *(const bf16x8*)(qgp + 16 * s);
    f32x16 o[4];
#pragma unroll
    for (int vb = 0; vb < 4; ++vb) {
        o[vb] = f32x16{};
#pragma unroll
        for (int s = 0; s < 4; ++s) { const float* s0 = sp + (size_t)(16 * s + 8 * hi) * 128 + 32 * vb + r;
            const bf16x8 bfv = pack8(s0[0], s0[128], s0[256], s0[384], s0[512], s0[640], s0[768], s0[896]);
            o[vb] = MFMA32(qf[s], bfv, o[vb]); }
        asm volatile("" ::: "memory");
    }
    g3_tile_in((const bf16*)(c.ws + O_OINTRA) + row0 * 512 + h * 128, R, lane);
#pragma unroll
    for (int vb = 0; vb < 4; ++vb) {
#pragma unroll
        for (int rg = 0; rg < 16; ++rg) o[vb][rg] += bf2f(*(const LAS bf16*)(Re + ((rg & 3) + 8 * (rg >> 2)) * G3_PITCH + 64 * vb));
        asm volatile("" ::: "memory");
    }
    float rs[16];
#pragma unroll
    for (int rg = 0; rg < 16; ++rg) { float ss = o[0][rg] * o[0][rg] + o[1][rg] * o[1][rg] + o[2][rg] * o[2][rg] + o[3][rg] * o[3][rg];
        ss += __shfl_xor(ss, 1); ss += __shfl_xor(ss, 2); ss += __shfl_xor(ss, 4); ss += __shfl_xor(ss, 8); ss += __shfl_xor(ss, 16);
        rs[rg] = 1.f / sqrtf(ss * (1.f / 128.f) + EPS); }
    LDS_WAIT();
    g3_tile_in((const bf16*)(c.ws + O_GR) + row0 * 512 + h * 128, R, lane);
#pragma unroll
    for (int vb = 0; vb < 4; ++vb) { const float g = gn[32 * vb + r];
#pragma unroll
        for (int rg = 0; rg < 16; ++rg) { LAS bf16* e = (LAS bf16*)(R + (4 * hi) * G3_PITCH + r * 2 + ((rg & 3) + 8 * (rg >> 2)) * G3_PITCH + 64 * vb);
            const float z = bf2f(*e);
            *e = (bf16)(cvtpk(o[vb][rg] * rs[rg] * g * siluf_(z), 0.f) & 0xffffu); }
        asm volatile("" ::: "memory"); }
    g3_tile_out((bf16*)(c.ws + O_OGLA) + row0 * 512 + h * 128, R, lane);
}
constexpr int A_KT = 0, A_VT = 16384, A_WSF = 32768, A_IMP = 36864, A_SEL = A_IMP + 65536, A_OC = A_SEL + 512, A_END = A_OC + 32768;
struct ASt { float m, l; f32x16 o0, o1; };
struct TileRegs { u32x4 k, v; };
DI TileRegs tile_fetch(const bf16* Kg, const bf16* Vg, int tok0, int tid) {
    TileRegs t; const size_t off = (size_t)(tok0 + (tid >> 3)) * 64 + (tid & 7) * 8;
    t.k = *(const u32x4*)(Kg + off); t.v = *(const u32x4*)(Vg + off); return t;
}
DI void tile_stage(const TileRegs& t, LAS unsigned char* lds, int buf, int tid) {
    const int kv = tid >> 3, ch = tid & 7;
    *(LAS u32x4*)(lds + A_KT + buf * 8192 + ch * 1024 + ((kv ^ (2 * ch)) * 16)) = t.k;
    *(LAS u32x4*)(lds + A_VT + buf * 8192 + (ch >> 2) * 4096 + kv * 64 + (ch & 3) * 16) = t.v;
}
template <bool CMP> DI void tile_compute(LAS unsigned char* lds, int buf, const bf16x8 (&q)[4], int lo, int hv, ASt& st, f32x16& imp0, f32x16& imp1, int jt, LAS float* wsf, int lane) {
    const int r = lane & 31, hi = lane >> 5;
    const LAS unsigned char* kb0 = lds + A_KT + buf * 8192 + hi * 1024;
    f32x16 p0 = {}, p1 = {};
#pragma unroll
    for (int s = 0; s < 4; ++s) { const LAS unsigned char* kb = kb0 + ((r ^ (4 * s + 2 * hi)) * 16);
        const bf16x8 a0 = *(const LAS bf16x8*)(kb + s * 2048), a1 = *(const LAS bf16x8*)(kb + s * 2048 + 512);
        p0 = MFMA32(a0, q[s], p0); p1 = MFMA32(a1, q[s], p1); }
    const bool dead = lo > hv;
    const bool part = !dead && (lo > 0 || hv < 63);
    const bool anyPart = __builtin_amdgcn_ballot_w64(part) != 0ull;
    if (anyPart) {
#pragma unroll
        for (int rg = 0; rg < 16; ++rg) { const int k0 = crow(rg, hi), k1 = k0 + 32;
            p0[rg] = (k0 >= lo && k0 <= hv) ? p0[rg] : NEGB; p1[rg] = (k1 >= lo && k1 <= hv) ? p1[rg] : NEGB; }
    }
    float mx = __builtin_fmaxf(p0[0], p1[0]);
#pragma unroll
    for (int rg = 1; rg < 16; ++rg) mx = __builtin_fmaxf(__builtin_fmaxf(mx, p0[rg]), p1[rg]);
    if (!anyPart && dead) mx = NEGB;
    mx = __builtin_fmaxf(mx, __shfl_xor(mx, 32));
    const float mnew = fmaxf(st.m, mx);
    const float alpha = __builtin_amdgcn_exp2f(st.m - mnew);
    st.m = mnew;
    float sum = 0.f;
    const float msub = (!anyPart && dead) ? 1e30f : mnew;
#pragma unroll
    for (int rg = 0; rg < 16; ++rg) { p0[rg] = __builtin_amdgcn_exp2f(p0[rg] - msub); p1[rg] = __builtin_amdgcn_exp2f(p1[rg] - msub); sum += p0[rg] + p1[rg]; }
    st.l = st.l * alpha + sum;
    if (__builtin_amdgcn_ballot_w64(alpha != 1.f) != 0ull) {
        if (hi == 0) wsf[r] = alpha;
        LDS_WAIT();
#pragma unroll
        for (int g4 = 0; g4 < 4; ++g4) { const f32x4 f = *(const LAS f32x4*)(wsf + 8 * g4 + 4 * hi);
#pragma unroll
            for (int k = 0; k < 4; ++k) { st.o0[4 * g4 + k] *= f[k]; st.o1[4 * g4 + k] *= f[k]; if (CMP) { imp0[4 * g4 + k] *= f[k]; imp1[4 * g4 + k] *= f[k]; } } }
        LDS_WAIT();
    }
    bf16x8 pa[4];
    pa[0] = pack8(p0[0], p0[1], p0[2], p0[3], p0[4], p0[5], p0[6], p0[7]); pa[1] = pack8(p0[8], p0[9], p0[10], p0[11], p0[12], p0[13], p0[14], p0[15]);
    pa[2] = pack8(p1[0], p1[1], p1[2], p1[3], p1[4], p1[5], p1[6], p1[7]); pa[3] = pack8(p1[8], p1[9], p1[10], p1[11], p1[12], p1[13], p1[14], p1[15]);
    const LAS unsigned char* vb = lds + A_VT + buf * 8192 + (4 * hi + ((lane & 15) >> 2)) * 64 + ((lane >> 4) & 1) * 32 + (lane & 3) * 8;
#pragma unroll
    for (int s = 0; s < 4; ++s) {
        const bf16x8 v0 = cat8(vtr(vb + s * 1024), vtr(vb + s * 1024 + 512));
        const bf16x8 v1 = cat8(vtr(vb + 4096 + s * 1024), vtr(vb + 4096 + s * 1024 + 512));
        st.o0 = MFMA32(pa[s], v0, st.o0); st.o1 = MFMA32(pa[s], v1, st.o1);
    }
    if (CMP) {
#pragma unroll
        for (int s = 0; s < 4; ++s) {
            bf16x8 w0, w1;
#pragma unroll
            for (int j = 0; j < 8; ++j) { const int jj = 64 * jt + 16 * s + 8 * (j >> 2) + 4 * hi + (j & 3);
                const int n0 = r, n1 = 32 + r;
                w0[j] = (jj >= 4 * n0 - 1 && jj <= 4 * n0 + 3) ? (short)0x3F80 : (short)0;
                w1[j] = (jj >= 4 * n1 - 1 && jj <= 4 * n1 + 3) ? (short)0x3F80 : (short)0; }
            imp0 = MFMA32(pa[s], w0, imp0); imp1 = MFMA32(pa[s], w1, imp1); asm volatile("" ::: "memory");
        }
    }
}
DI void branch_fold(ASt& st, float gate, bool may_be_empty, LAS float* wsf, int lane) {
    const int r = lane & 31, hi = lane >> 5;
    const float lt = st.l + __shfl_xor(st.l, 32);
    float inv = 1.f / lt; if (may_be_empty && !(st.m > -1e29f)) inv = 0.f;
    if (hi == 0) { wsf[r] = inv * gate; wsf[32 + r] = inv; }
    LDS_WAIT();
#pragma unroll
    for (int g4 = 0; g4 < 4; ++g4) { const f32x4 f = *(const LAS f32x4*)(wsf + 8 * g4 + 4 * hi);
#pragma unroll
        for (int k = 0; k < 4; ++k) { st.o0[4 * g4 + k] *= f[k]; st.o1[4 * g4 + k] *= f[k]; } }
}
DI void nsa_unit(const Ctx& c0, int b, int g, int i, LAS unsigned char* lds) {
    const Ctx c = launder(c0);
    const int tid = c.tid, lane = c.lane, wid = c.wid, r = lane & 31, hi = lane >> 5;
    const int hl = wid >> 1, qh = wid & 1, head = g * 4 + hl, ql = 32 * qh + r, t = i * 64 + ql;
    const size_t row = (size_t)b * SEQ + t;
    LAS float* wsf = (LAS float*)(lds + A_WSF) + wid * 64;
    LAS float* IMP = (LAS float*)(lds + A_IMP);
    LAS unsigned long long* SEL = (LAS unsigned long long*)(lds + A_SEL);
    const bf16* misc = (const bf16*)(c.ws + O_MISC);
    bf16x8 qn[4];
    { const bf16* qp = (const bf16*)(c.ws + O_QN) + row * 512 + head * 64 + 8 * hi;
#pragma unroll
      for (int s = 0; s < 4; ++s) qn[s] = *(const bf16x8*)(qp + 16 * s); }
    const float g_c = sigmoidf_(bf2f(misc[row * 64 + head * 3 + 0])), g_s = sigmoidf_(bf2f(misc[row * 64 + head * 3 + 1])), g_w = sigmoidf_(bf2f(misc[row * 64 + head * 3 + 2]));
#ifdef PROBE_NOC
    const float g_c2 = 0.f;
#else
    const float g_c2 = g_c;
#endif
#ifdef PROBE_NOS
    const float g_s2 = 0.f;
#else
    const float g_s2 = g_s;
#endif
#ifdef PROBE_NOW
    const float g_w2 = 0.f;
#else
    const float g_w2 = g_w;
#endif
    f32x16 dum0 = {}, dum1 = {};
    LAS float* OACC = (LAS float*)(lds + A_IMP) + wid * 2048 + lane;
    LAS unsigned* OC = (LAS unsigned*)(lds + A_OC) + wid * 1024 + lane;
    f32x16 ca0, ca1;
#ifndef SKN_CMP
    {
        const bf16* Kg = (const bf16*)(c.ws + O_KCMP) + ((size_t)(0 + g) * 2048 + b * 256) * 64;
        const bf16* Vg = (const bf16*)(c.ws + O_KCMP) + ((size_t)(2 + g) * 2048 + b * 256) * 64;
        const int nt = (4 * i + 3 + 63) >> 6;
        const int jmax = (t - 31) >> 4;
        ASt st; st.m = NEGB; st.l = 0.f; st.o0 = f32x16{}; st.o1 = f32x16{};
        f32x16 imp0 = {}, imp1 = {};
        TileRegs tr = tile_fetch(Kg, Vg, 0, tid);
        for (int k = 0; k < nt; ++k) {
            tile_stage(tr, lds, k & 1, tid);
            __syncthreads();
            if (k + 1 < nt) tr = tile_fetch(Kg, Vg, 64 * (k + 1), tid);
            int hv = jmax - 64 * k; hv = hv > 63 ? 63 : hv; const int lo = hv < 0 ? 64 : 0;
            tile_compute<true>(lds, k & 1, qn, lo, hv, st, imp0, imp1, k, wsf, lane);
        }
        branch_fold(st, g_c2, true, wsf, lane);
#pragma unroll
        for (int rg = 0; rg < 16; ++rg) OC[rg * 64] = cvtpk(st.o0[rg], st.o1[rg]);
#pragma unroll
        for (int g4 = 0; g4 < 4; ++g4) { const f32x4 f = *(const LAS f32x4*)(wsf + 32 + 8 * g4 + 4 * hi);
#pragma unroll
            for (int k = 0; k < 4; ++k) { const int qq = 32 * qh + 8 * g4 + 4 * hi + k;
                IMP[(hl * 64 + qq) * 64 + r] = imp0[4 * g4 + k] * f[k]; IMP[(hl * 64 + qq) * 64 + 32 + r] = imp1[4 * g4 + k] * f[k]; } }
        __syncthreads();
    }
#endif
    unsigned long long mysel, um;
    {
        const unsigned long long validm = (i >= 63) ? ~0ull : ((1ull << (i + 1)) - 1ull);
        if (i >= 16) {
            for (int qq = 8 * wid; qq < 8 * wid + 8; ++qq) {
                const int n = lane;
                const float v = ((IMP[(0 * 64 + qq) * 64 + n] + IMP[(1 * 64 + qq) * 64 + n]) + IMP[(2 * 64 + qq) * 64 + n]) + IMP[(3 * 64 + qq) * 64 + n];
                unsigned key = (__float_as_uint(fmaxf(v, 0.f)) & ~63u) | (unsigned)(63 - n);
                if (n == 0 || n == i || n == i - 1) key = 0xFFFFFFFFu;
                if (n > i) key = 0u;
                unsigned thr = 0u;
                for (int bit = 31; bit >= 0; --bit) { const unsigned cand = thr | (1u << bit);
                    const int cnt = __builtin_popcountll(__builtin_amdgcn_ballot_w64(key >= cand)); if (cnt >= 16) thr = cand; }
                const unsigned long long sm = __builtin_amdgcn_ballot_w64(key >= thr) & validm;
                if (lane == 0) SEL[qq] = sm;
            }
            __syncthreads();
            mysel = SEL[ql];
            unsigned long long u = SEL[lane];
            unsigned ulo = (unsigned)u, uhi = (unsigned)(u >> 32);
#pragma unroll
            for (int o = 1; o < 64; o <<= 1) { ulo |= __shfl_xor(ulo, o); uhi |= __shfl_xor(uhi, o); }
            um = ((unsigned long long)uhi << 32) | ulo;
        } else { mysel = validm; um = validm; }
    }
    bf16x8 qr[4];
    { const float* ct = (const float*)(c.ws + O_TAB) + (size_t)t * 32; const float* stb = ct + 4096 * 32;
#pragma unroll
      for (int s = 0; s < 2; ++s) {
          const f32x4 c0 = *(const f32x4*)(ct + 16 * s + 8 * hi), c1 = *(const f32x4*)(ct + 16 * s + 8 * hi + 4);
          const f32x4 s0 = *(const f32x4*)(stb + 16 * s + 8 * hi), s1 = *(const f32x4*)(stb + 16 * s + 8 * hi + 4);
          float lo_[8], hi_[8], ol[8], oh[8];
#pragma unroll
          for (int j = 0; j < 8; ++j) { lo_[j] = bf2f((bf16)qn[s][j]); hi_[j] = bf2f((bf16)qn[s + 2][j]); }
#pragma unroll
          for (int j = 0; j < 8; ++j) { const float cc = j < 4 ? c0[j & 3] : c1[j & 3], ss = j < 4 ? s0[j & 3] : s1[j & 3];
              ol[j] = lo_[j] * cc - hi_[j] * ss; oh[j] = hi_[j] * cc + lo_[j] * ss; }
          qr[s] = pack8(ol[0], ol[1], ol[2], ol[3], ol[4], ol[5], ol[6], ol[7]); qr[s + 2] = pack8(oh[0], oh[1], oh[2], oh[3], oh[4], oh[5], oh[6], oh[7]); } }
#ifndef SKN_SLC
    {
        const bf16* Kg = (const bf16*)(c.ws + O_KS) + ((size_t)g * T + (size_t)b * SEQ) * 64;
        const bf16* Vg = (const bf16*)(c.ws + O_VS) + ((size_t)g * T + (size_t)b * SEQ) * 64;
        ASt st; st.m = NEGB; st.l = 0.f; st.o0 = f32x16{}; st.o1 = f32x16{};
        unsigned long long rem = um;
        int n = __builtin_ctzll(rem); rem &= rem - 1ull;
        TileRegs tr = tile_fetch(Kg, Vg, 64 * n, tid);
        int k = 0;
        for (;;) {
            tile_stage(tr, lds, k & 1, tid);
            __syncthreads();
            const bool more = rem != 0ull; int nn = 0;
            if (more) { nn = __builtin_ctzll(rem); rem &= rem - 1ull; tr = tile_fetch(Kg, Vg, 64 * nn, tid); }
            const bool selb = (mysel >> n) & 1ull;
            const int lo = selb ? 0 : 64; const int hv = (n == i) ? ql : 63;
            tile_compute<false>(lds, k & 1, qr, lo, hv, st, dum0, dum1, 0, wsf, lane);
            ++k; if (!more) break; n = nn;
        }
        branch_fold(st, g_s2, false, wsf, lane);
#pragma unroll
        for (int rg = 0; rg < 16; ++rg) { OACC[rg * 64] = st.o0[rg]; OACC[(16 + rg) * 64] = st.o1[rg]; }
        __syncthreads();
    }
#endif
#ifndef SKN_WIN
    {
        const bf16* Kg = (const bf16*)(c.ws + O_KW) + ((size_t)g * T + (size_t)b * SEQ) * 64;
        const bf16* Vg = (const bf16*)(c.ws + O_VW) + ((size_t)g * T + (size_t)b * SEQ) * 64;
        ASt st; st.m = NEGB; st.l = 0.f; st.o0 = f32x16{}; st.o1 = f32x16{};
        const int nlast = i - 8 < 0 ? 0 : i - 8;
        TileRegs tr = tile_fetch(Kg, Vg, 64 * i, tid);
        int k = 0;
        for (int n = i; n >= nlast; --n, ++k) {
            tile_stage(tr, lds, k & 1, tid);
            __syncthreads();
            if (n - 1 >= nlast) tr = tile_fetch(Kg, Vg, 64 * (n - 1), tid);
            int lo = 0, hv = 63;
            if (n == i) hv = ql;
            if (n == i - 8) lo = ql + 1;
            tile_compute<false>(lds, k & 1, qr, lo, hv, st, dum0, dum1, 0, wsf, lane);
        }
        branch_fold(st, g_w2, false, wsf, lane);
#pragma unroll
        for (int rg = 0; rg < 16; ++rg) { const unsigned w = OC[rg * 64]; ca0[rg] = (OACC[rg * 64] + st.o0[rg]) + bflo(w); ca1[rg] = (OACC[(16 + rg) * 64] + st.o1[rg]) + bfhi(w); }
        __syncthreads();
    }
#endif
    { const size_t g0 = ((size_t)b * SEQ + i * 64 + 32 * qh) * 512 + head * 64;
      const bf16* nzg = (const bf16*)(c.ws + O_NZ) + g0; bf16* ong = (bf16*)(c.ws + O_ONSA) + g0;
      LAS unsigned char* S = lds + A_OC + wid * 4096;
#pragma unroll
      for (int it = 0; it < 4; ++it) { const int rw = 8 * it + (lane >> 3), ch = lane & 7;
          *(LAS u32x4*)(S + rw * 128 + ch * 16) = *(const u32x4*)(nzg + (size_t)rw * 512 + ch * 8); }
      LDS_WAIT();
#pragma unroll
      for (int rg = 0; rg < 16; ++rg) { LAS bf16* e = (LAS bf16*)(S + ((rg & 3) + 8 * (rg >> 2) + 4 * hi) * 128 + r * 2);
          const float z0 = bf2f(e[0]), z1 = bf2f(e[32]);
          e[0] = (bf16)(cvtpk(ca0[rg] * siluf_(z0), 0.f) & 0xffffu);
          e[32] = (bf16)(cvtpk(ca1[rg] * siluf_(z1), 0.f) & 0xffffu); }
      LDS_WAIT();
#pragma unroll
      for (int it = 0; it < 4; ++it) { const int rw = 8 * it + (lane >> 3), ch = lane & 7;
          *(u32x4*)(ong + (size_t)rw * 512 + ch * 8) = *(const LAS u32x4*)(S + rw * 128 + ch * 16); }
      LDS_WAIT(); }
}
DI void cmp_stage2(const Ctx& c0, int layer) {
    const Ctx c = launder(c0);
    const float* cp = (const float*)(c.ws + O_CPART); const float* cb = (const float*)(c.ws + O_CBIAS) + layer * 256;
    bf16* out = (bf16*)(c.ws + O_KCMP);
    for (int task = (c.tid < 256) ? (int)blockIdx.x * 256 + c.tid : 4 * 2048 * 8; task < 4 * 2048 * 8; task += c.G * 256) {
        const int oct = task & 7, row = (task >> 3) & 2047, which = task >> 14, kv = which >> 1;
        const float* w2 = c.a->in[kv ? I_CW2V : I_CW2K] + (size_t)layer * 128 * 64 + 8 * oct;
        const float* p0 = cp + ((size_t)which * 2048 + row) * 128;
        float acc[8] = {0.f, 0.f, 0.f, 0.f, 0.f, 0.f, 0.f, 0.f};
        for (int h4 = 0; h4 < 128; h4 += 4) {
            f32x4 s = *(const f32x4*)(p0 + h4);
#pragma unroll
            for (int ks = 1; ks < 4; ++ks) s += *(const f32x4*)(p0 + (size_t)ks * 4 * 2048 * 128 + h4);
            s += *(const f32x4*)(cb + kv * 128 + h4);
#pragma unroll
            for (int j = 0; j < 4; ++j) { const float hv = siluf_(s[j]); const f32x4 w0 = *(const f32x4*)(w2 + (size_t)(h4 + j) * 64), w1 = *(const f32x4*)(w2 + (size_t)(h4 + j) * 64 + 4);
                acc[0] += hv * w0[0]; acc[1] += hv * w0[1]; acc[2] += hv * w0[2]; acc[3] += hv * w0[3]; acc[4] += hv * w1[0]; acc[5] += hv * w1[1]; acc[6] += hv * w1[2]; acc[7] += hv * w1[3]; }
        }
        u32x4 w; w.x = cvtpk(acc[0], acc[1]); w.y = cvtpk(acc[2], acc[3]); w.z = cvtpk(acc[4], acc[5]); w.w = cvtpk(acc[6], acc[7]);
        *(u32x4*)(out + ((size_t)which * 2048 + row) * 64 + 8 * oct) = w;
    }
}
DI void post_phase(const Ctx& c0, int layer) {
    const Ctx c = launder(c0);
    const bf16* ob = (const bf16*)(c.ws + O_OUTB); const float* xin = layer == 0 ? c.a->in[I_X] : c.out;
    const float* gp = c.a->in[I_GPOST] + (size_t)layer * DM; const float* gn = c.a->in[I_GPRE] + (size_t)(layer + 1 < 2 ? layer + 1 : 1) * DM;
    const int gw = blockIdx.x * 8 + c.wid, NGW = c.G * 8, lane = c.lane;
    for (int m = gw; m < T; m += NGW) {
        float o[16]; float ss = 0.f;
#pragma unroll
        for (int j = 0; j < 2; ++j) { const u32x4 w = *(const u32x4*)(ob + (size_t)m * DM + 512 * j + 8 * lane);
            o[8 * j + 0] = bflo(w.x); o[8 * j + 1] = bfhi(w.x); o[8 * j + 2] = bflo(w.y); o[8 * j + 3] = bfhi(w.y); o[8 * j + 4] = bflo(w.z); o[8 * j + 5] = bfhi(w.z); o[8 * j + 6] = bflo(w.w); o[8 * j + 7] = bfhi(w.w); }
#pragma unroll
        for (int e = 0; e < 16; ++e) ss += o[e] * o[e];
        const float rr = 1.f / sqrtf(wave_sum(ss) * (1.f / 1024.f) + EPS);
        float xn[16]; float s2 = 0.f;
#pragma unroll
        for (int j = 0; j < 2; ++j)
#pragma unroll
            for (int q = 0; q < 2; ++q) { const size_t off = (size_t)m * DM + 512 * j + 8 * lane + 4 * q; const f32x4 xv = *(const f32x4*)(xin + off); const f32x4 g = *(const f32x4*)(gp + 512 * j + 8 * lane + 4 * q);
                f32x4 y;
#pragma unroll
                for (int k = 0; k < 4; ++k) { y[k] = xv[k] + o[8 * j + 4 * q + k] * rr * g[k]; xn[8 * j + 4 * q + k] = y[k]; s2 += y[k] * y[k]; }
                *(f32x4*)(c.out + off) = y; }
        if (layer == 0) {
            const float r2 = 1.f / sqrtf(wave_sum(s2) * (1.f / 1024.f) + EPS);
            bf16* hb = (bf16*)(c.ws + O_HB) + (size_t)m * DM;
#pragma unroll
            for (int j = 0; j < 2; ++j) { const f32x4 g0 = *(const f32x4*)(gn + 512 * j + 8 * lane), g1 = *(const f32x4*)(gn + 512 * j + 8 * lane + 4);
                u32x4 w; w.x = cvtpk(xn[8 * j] * r2 * g0[0], xn[8 * j + 1] * r2 * g0[1]); w.y = cvtpk(xn[8 * j + 2] * r2 * g0[2], xn[8 * j + 3] * r2 * g0[3]);
                w.z = cvtpk(xn[8 * j + 4] * r2 * g1[0], xn[8 * j + 5] * r2 * g1[1]); w.w = cvtpk(xn[8 * j + 6] * r2 * g1[2], xn[8 * j + 7] * r2 * g1[3]);
                *(u32x4*)(hb + 512 * j + 8 * lane) = w; }
        }
    }
}

constexpr size_t O_BAR = O_CBIAS + 65536;
DI Ctx make_ctx(const Args& a) {
    Ctx cb; cb.a = &a; cb.out = a.out; cb.ws = a.ws; cb.tid = threadIdx.x; cb.lane = cb.tid & 63; cb.wid = __builtin_amdgcn_readfirstlane(cb.tid >> 6); cb.G = gridDim.x;
    { const int bx = blockIdx.x; cb.vcu = (cb.G % 8 == 0) ? (bx % 8) * (cb.G / 8) + bx / 8 : bx; }
    return cb;
}
template <int PH> DI void run_phase(const Ctx& cb, LAS unsigned char* lds, int layer) {
    if constexpr (PH == 0) { phase0(cb, lds); }
    if constexpr (PH == 1) { const Ctx c = launder(cb); pg8::Gemm g{(const pg8::bf16_t*)(c.ws + O_HB), (const pg8::bf16_t*)(c.ws + O_WIN + (size_t)layer * 11 * MiB), T, NPHYS, 1024, 1024, 1024};
        pg8::StaticOrder S; S.init(T, NPHYS, c.G, (int)blockIdx.x); EpiProj E{c.ws};
        pg8::gemm_phase<EpiProj, pg8::StaticOrder, true, true>(lds, g, S, E); }
    if constexpr (PH == 2) {
        { const Ctx c = launder(cb);
          for (int cu = blockIdx.x; cu < 128; cu += c.G) { const int which = cu >> 5, ks = (cu >> 3) & 3, pm = cu & 7, kv = which >> 1;
            pg8::Gemm g{(const pg8::bf16_t*)(c.ws + O_KCRAW) + (size_t)which * KCR_ROWS * 64 + ks * 512,
                        (const pg8::bf16_t*)(c.ws + O_WC1 + (size_t)(layer * 2 + kv) * MiB) + ks * 512, 2048, 256, 512, 1024, 2048};
            OneUnit S{pm, true}; EpiCPart E{(float*)(c.ws + O_CPART) + ((size_t)(ks * 4 + which) * 2048) * 128};
            pg8::gemm_phase<EpiCPart, OneUnit, false, true>(lds, g, S, E); } }
        __syncthreads();
        {
          const int bx = blockIdx.x; const bool bal = cb.G == 256;
          const int nun = bal ? (bx < 128 ? 7 : 9) : (2048 - bx + cb.G - 1) / cb.G;
          for (int k = 0; k < nun; ++k) { const int u = bal ? (k < 7 ? bx + 256 * k : 1792 + 2 * (bx - 128) + (k - 7)) : bx + cb.G * k; gla_stage1(cb, layer, u, lds); } }
    }
    if constexpr (PH == 3) { cmp_stage2(cb, layer); { const Ctx c = launder(cb); gla_stage2(c); } }
    if constexpr (PH == 4) {
        for (int sl = cb.vcu; sl < 256; sl += cb.G) { const int bg = sl >> 4, s = sl & 15;
#pragma unroll 1
            for (int it = 0; it < 4; ++it) { const int i = (it == 0) ? s : (it == 1) ? 31 - s : (it == 2) ? 32 + s : 63 - s; nsa_unit(cb, bg >> 1, bg & 1, i, lds); } }
        __syncthreads();
        for (int pu = blockIdx.x * 4 + (cb.wid >> 1); pu < 2048; pu += cb.G * 4) gla_stage3(cb, layer, pu, cb.wid & 1, lds);
#ifdef PROBE_G3X2
        __syncthreads();
        for (int pu = blockIdx.x * 4 + (cb.wid >> 1); pu < 2048; pu += cb.G * 4) gla_stage3(cb, layer, pu, cb.wid & 1, lds);
#endif
    }
    if constexpr (PH == 5) {
        { const Ctx c = launder(cb); pg8::Gemm g{(const pg8::bf16_t*)(c.ws + O_ONSA), (const pg8::bf16_t*)(c.ws + O_WUPN + (size_t)layer * MiB), T, 1024, 512, 512, 512};
          pg8::StaticOrder S; S.init(T, 1024, c.G, (int)blockIdx.x); EpiUp<false> E{(const bf16*)(c.ws + O_MG), (bf16*)(c.ws + O_Y)};
          pg8::gemm_phase<EpiUp<false>, pg8::StaticOrder, true, true>(lds, g, S, E); }
        __syncthreads();
        { const Ctx c = launder(cb); pg8::Gemm g{(const pg8::bf16_t*)(c.ws + O_OGLA), (const pg8::bf16_t*)(c.ws + O_WUPG + (size_t)layer * MiB), T, 1024, 512, 512, 512};
          pg8::StaticOrder S; S.init(T, 1024, c.G, (int)blockIdx.x); EpiUp<true> E{(const bf16*)(c.ws + O_MG) + 1024, (bf16*)(c.ws + O_Y)};
          pg8::gemm_phase<EpiUp<true>, pg8::StaticOrder, true, true>(lds, g, S, E); }
    }
    if constexpr (PH == 6) { const Ctx c = launder(cb); pg8::Gemm g{(const pg8::bf16_t*)(c.ws + O_Y), (const pg8::bf16_t*)(c.ws + O_WOUT + (size_t)layer * 2 * MiB), T, 1024, 1024, 1024, 1024};
        pg8::StaticOrder S; S.init(T, 1024, c.G, (int)blockIdx.x); EpiPlain E{(bf16*)(c.ws + O_OUTB), 1024};
        pg8::gemm_phase<EpiPlain, pg8::StaticOrder, true, true>(lds, g, S, E); }
    if constexpr (PH == 7) { post_phase(cb, layer); }
}
#ifndef ONE_LAUNCH
#define ONE_LAUNCH 1
#endif
#ifndef PLAN
#define PLAN 0
#endif
#if ONE_LAUNCH
template <int L> DI void run_layer(const Ctx& cb, LAS unsigned char* lds, const XcdBarrier& xbar, bool last) {
    run_phase<1>(cb, lds, L); xcd_barrier(xbar);
    run_phase<2>(cb, lds, L); xcd_barrier(xbar);
    run_phase<3>(cb, lds, L); xcd_barrier(xbar);
    run_phase<4>(cb, lds, L); xcd_barrier(xbar);
    run_phase<5>(cb, lds, L); xcd_barrier(xbar);
    run_phase<6>(cb, lds, L); xcd_barrier(xbar);
    run_phase<7>(cb, lds, L); if (!last) xcd_barrier(xbar);
}
__global__ void __launch_bounds__(512, 2) nsa_gla_fwd(Args a) {
    extern __shared__ __attribute__((aligned(16))) unsigned char lds_raw[];
    LAS unsigned char* lds = (LAS unsigned char*)lds_raw;
    cg::grid_group grid = cg::this_grid();
    const Ctx cb = make_ctx(a);
    volatile LAS unsigned* bst = (volatile LAS unsigned*)(lds + LDS_BYTES - 64);
    if (threadIdx.x == 0) { bst[0] = 0u; bst[1] = 0u; }
    __syncthreads();
    const XcdBarrier xbar = xcd_barrier_post((unsigned*)(a.ws + O_BAR), bst);
    run_phase<0>(cb, lds, 0);
    xcd_barrier(xbar);
    run_layer<0>(cb, lds, xbar, false);
    run_layer<1>(cb, lds, xbar, true);
    if (gridDim.x > 100000u) grid.sync();
}
#else
template <int PH> __global__ void __launch_bounds__(512, 2) k_phase(Args a, int layer) {
    extern __shared__ __attribute__((aligned(16))) unsigned char lds_raw[];
    LAS unsigned char* lds = (LAS unsigned char*)lds_raw;
    const Ctx cb = make_ctx(a);
    run_phase<PH>(cb, lds, layer);
}
template <int LO, int HI> __global__ void __launch_bounds__(512, 2) k_range(Args a, int layer, int region) {
    extern __shared__ __attribute__((aligned(16))) unsigned char lds_raw[];
    LAS unsigned char* lds = (LAS unsigned char*)lds_raw;
    cg::grid_group grid = cg::this_grid();
    const Ctx cb = make_ctx(a);
    volatile LAS unsigned* bst = (volatile LAS unsigned*)(lds + LDS_BYTES - 64);
    if (threadIdx.x == 0) { bst[0] = 0u; bst[1] = 0u; }
    __syncthreads();
    const XcdBarrier xbar = xcd_barrier_post((unsigned*)(a.ws + O_BAR) + 4096 * region, bst);
    if constexpr (LO <= 1 && 1 <= HI) { run_phase<1>(cb, lds, layer); if constexpr (1 < HI) xcd_barrier(xbar); }
    if constexpr (LO <= 2 && 2 <= HI) { run_phase<2>(cb, lds, layer); if constexpr (2 < HI) xcd_barrier(xbar); }
    if constexpr (LO <= 3 && 3 <= HI) { run_phase<3>(cb, lds, layer); if constexpr (3 < HI) xcd_barrier(xbar); }
    if constexpr (LO <= 4 && 4 <= HI) { run_phase<4>(cb, lds, layer); if constexpr (4 < HI) xcd_barrier(xbar); }
    if constexpr (LO <= 5 && 5 <= HI) { run_phase<5>(cb, lds, layer); if constexpr (5 < HI) xcd_barrier(xbar); }
    if constexpr (LO <= 6 && 6 <= HI) { run_phase<6>(cb, lds, layer); if constexpr (6 < HI) xcd_barrier(xbar); }
    if constexpr (LO <= 7 && 7 <= HI) { run_phase<7>(cb, lds, layer); }
    if (layer > 1000) grid.sync();
}
template <int LO, int HI> static void launch_range(const Args& a, int layer, int region, hipStream_t stream) {
    static bool attr = false;
    if (!attr) { (void)hipFuncSetAttribute((const void*)k_range<LO, HI>, hipFuncAttributeMaxDynamicSharedMemorySize, LDS_BYTES); attr = true; }
    Args aa = a; int ll = layer, rr = region; void* args[] = {&aa, &ll, &rr};
    hipError_t e = hipLaunchCooperativeKernel((const void*)k_range<LO, HI>, dim3(256), dim3(512), args, LDS_BYTES, stream);
    if (e != hipSuccess) fprintf(stderr, "k_range<%d,%d> cooperative launch failed: %s\n", LO, HI, hipGetErrorString(e));
}
template <int PH> static void launch_phase(const Args& a, int layer, hipStream_t stream) {
    static bool attr = false;
    if (!attr) { (void)hipFuncSetAttribute((const void*)k_phase<PH>, hipFuncAttributeMaxDynamicSharedMemorySize, LDS_BYTES); attr = true; }
    hipLaunchKernelGGL(k_phase<PH>, dim3(256), dim3(512), LDS_BYTES, stream, a, layer);
}
#endif

extern "C" void kernel_launch(void* const* d_in, const int* in_sizes, int n_in, void* d_out, int out_size, void* d_ws, size_t ws_size, hipStream_t stream) {
    if (n_in != 16 || ws_size < WS_END) { fprintf(stderr, "kernel_launch: need 16 inputs and %zu bytes of workspace (got %d, %zu)\n", (size_t)WS_END, n_in, ws_size); return; }
    Args a{};
    for (int i = 0; i < 16; ++i) a.in[i] = (const float*)d_in[i];
    a.out = (float*)d_out; a.ws = (unsigned char*)d_ws;
#if ONE_LAUNCH
    static int grid = 0;
    if (grid == 0) {
        int dev = 0, cus = 0, per_cu = 0;
        (void)hipGetDevice(&dev); (void)hipDeviceGetAttribute(&cus, hipDeviceAttributeMultiprocessorCount, dev);
        if (hipFuncSetAttribute((const void*)nsa_gla_fwd, hipFuncAttributeMaxDynamicSharedMemorySize, LDS_BYTES) != hipSuccess) { fprintf(stderr, "kernel_launch: hipFuncSetAttribute failed\n"); grid = -1; return; }
        if (hipOccupancyMaxActiveBlocksPerMultiprocessor(&per_cu, (const void*)nsa_gla_fwd, 512, LDS_BYTES) != hipSuccess || per_cu < 1) { fprintf(stderr, "kernel_launch: occupancy query gave %d\n", per_cu); per_cu = 1; }
        (void)hipGetLastError();
        grid = cus * per_cu; if (grid > 256) grid = 256;
    }
    if (grid < 0) return;
    if (hipMemsetAsync((char*)d_ws + O_BAR, 0, 16384, stream) != hipSuccess) { fprintf(stderr, "kernel_launch: memset failed\n"); return; }
    void* args[] = {&a};
    hipError_t e = hipLaunchCooperativeKernel((const void*)nsa_gla_fwd, dim3(grid), dim3(512), args, LDS_BYTES, stream);
    if (e != hipSuccess) fprintf(stderr, "cooperative launch failed: %s (grid %d)\n", hipGetErrorString(e), grid);
#else
    if (hipMemsetAsync((char*)d_ws + O_BAR, 0, 16 * 16384, stream) != hipSuccess) { fprintf(stderr, "kernel_launch: memset failed\n"); return; }
    launch_phase<0>(a, 0, stream);
    for (int layer = 0; layer < 2; ++layer) {
#if PLAN == 1
        launch_phase<1>(a, layer, stream); launch_range<2, 3>(a, layer, layer * 4 + 0, stream); launch_phase<4>(a, layer, stream); launch_range<5, 7>(a, layer, layer * 4 + 1, stream);
#elif PLAN == 2
        launch_range<1, 3>(a, layer, layer * 4 + 0, stream); launch_phase<4>(a, layer, stream); launch_range<5, 7>(a, layer, layer * 4 + 1, stream);
#elif PLAN == 3
        launch_range<1, 3>(a, layer, layer * 4 + 0, stream); launch_range<4, 7>(a, layer, layer * 4 + 1, stream);
#elif PLAN == 4
        launch_range<1, 7>(a, layer, layer * 4 + 0, stream);
#else
        launch_phase<1>(a, layer, stream); launch_phase<2>(a, layer, stream); launch_phase<3>(a, layer, stream); launch_phase<4>(a, layer, stream);
        launch_phase<5>(a, layer, stream); launch_phase<6>(a, layer, stream); launch_phase<7>(a, layer, stream);
#endif
    }
#endif
}
```
